# Optimizing an MI355X kernel written in HIP

```python
import jax, jax.numpy as jnp
from jax import lax
import numpy as np

D_MODEL = 1024
BATCH = 8
SEQ = 4096
DEPTH = 4

GRID_W = 64
BLOCK_Q = 128
CHUNK = 128
ROPE_THETA = 10000.0
EPS = 1e-6
A_HEADS = 8
A_KV_HEADS = 2
A_HEAD_DIM = 64
A_WIDTH = A_HEADS * A_HEAD_DIM
A_KV_WIDTH = A_KV_HEADS * A_HEAD_DIM
B_GROUPS = 4
B_GROUP_DIM = 128
B_WIDTH = B_GROUPS * B_GROUP_DIM
M_HEADS = 4
M_HEAD_DIM = 128
M_WIDTH = M_HEADS * M_HEAD_DIM
MEM_LEN = 256
N_BRANCH = 3
BRANCH_WIDTH = 512
IN_SPLITS = (A_WIDTH, A_KV_WIDTH, A_KV_WIDTH, A_WIDTH,
             B_WIDTH, B_WIDTH, B_WIDTH,
             M_WIDTH, M_WIDTH,
             N_BRANCH * D_MODEL)
IN_WIDTH = sum(IN_SPLITS)

kernel_name = "hybrid_gqa_gmlp_memory_encoder"


def _split_points():
    pts, acc = [], 0
    for s in IN_SPLITS[:-1]:
        acc += s
        pts.append(acc)
    return pts


def rms_norm(x, g):
    xf = x.astype(jnp.float32)
    y = xf * lax.rsqrt(jnp.mean(xf * xf, axis=-1, keepdims=True) + EPS)
    return (y * g.astype(jnp.float32)).astype(x.dtype)


def layer_norm(x, g, b):
    xf = x.astype(jnp.float32)
    mu = jnp.mean(xf, axis=-1, keepdims=True)
    xc = xf - mu
    y = xc * lax.rsqrt(jnp.mean(xc * xc, axis=-1, keepdims=True) + EPS)
    return (y * g.astype(jnp.float32) + b.astype(jnp.float32)).astype(x.dtype)


def axial_rope_tables(seq):
    rows = seq // GRID_W
    row = jnp.repeat(jnp.arange(rows, dtype=jnp.float32), GRID_W)
    col = jnp.tile(jnp.arange(GRID_W, dtype=jnp.float32), rows)
    n_freq = A_HEAD_DIM // 4
    inv = ROPE_THETA ** (-jnp.arange(n_freq, dtype=jnp.float32) / n_freq)
    ang = jnp.stack([row[:, None] * inv, col[:, None] * inv], axis=1)
    return jnp.cos(ang), jnp.sin(ang)


def apply_axial_rope(x, cos, sin):
    b, s, h, d = x.shape
    x5 = x.reshape(b, s, h, 2, 2, d // 4)
    x1, x2 = x5[..., 0, :], x5[..., 1, :]
    c = cos[None, :, None].astype(x.dtype)
    sn = sin[None, :, None].astype(x.dtype)
    out = jnp.stack([x1 * c - x2 * sn, x2 * c + x1 * sn], axis=-2)
    return out.reshape(b, s, h, d)


def gqa_axial_attention(q, k, v, q_g, k_g, cos, sin):
    bsz, seq, _ = q.shape
    grp = A_HEADS // A_KV_HEADS
    q = apply_axial_rope(rms_norm(q.reshape(bsz, seq, A_HEADS, A_HEAD_DIM), q_g), cos, sin)
    k = apply_axial_rope(rms_norm(k.reshape(bsz, seq, A_KV_HEADS, A_HEAD_DIM), k_g), cos, sin)
    v = v.reshape(bsz, seq, A_KV_HEADS, A_HEAD_DIM)
    scale = A_HEAD_DIM ** -0.5
    nblk = seq // BLOCK_Q
    qb = q.reshape(bsz, nblk, BLOCK_Q, A_KV_HEADS, grp, A_HEAD_DIM).transpose(1, 0, 3, 4, 2, 5)
    kt = k.transpose(0, 2, 1, 3)
    vt = v.transpose(0, 2, 1, 3)

    def one_block(qblk):
        s = jnp.einsum('bkgqd,bksd->bkgqs', qblk, kt,
                       preferred_element_type=jnp.float32) * scale
        p = jax.nn.softmax(s, axis=-1)
        return jnp.einsum('bkgqs,bksd->bkgqd', p.astype(vt.dtype), vt)

    o = lax.map(one_block, qb)
    return o.transpose(1, 0, 4, 2, 3, 5).reshape(bsz, seq, A_WIDTH)


def chunked_spatial_gating(u, v, ln_g, ln_b, w_s, b_s):
    bsz, seq, _ = v.shape
    v = layer_norm(v, ln_g, ln_b)
    vc = v.reshape(bsz, seq // CHUNK, CHUNK, B_GROUPS, B_GROUP_DIM)
    mixed = jnp.einsum('gpq,bnqgc->bnpgc', w_s, vc) + b_s.T[None, None, :, :, None]
    return u * mixed.reshape(bsz, seq, B_WIDTH)


def memory_cross_attention(q, mem_n, w_kv):
    bsz, seq, _ = q.shape
    kv = mem_n @ w_kv
    k, v = jnp.split(kv, 2, axis=-1)
    k = k.reshape(bsz, -1, M_HEADS, M_HEAD_DIM)
    v = v.reshape(bsz, -1, M_HEADS, M_HEAD_DIM)
    q = q.reshape(bsz, seq, M_HEADS, M_HEAD_DIM)
    s = jnp.einsum('bshd,bmhd->bhsm', q, k,
                   preferred_element_type=jnp.float32) * (M_HEAD_DIM ** -0.5)
    p = jax.nn.softmax(s, axis=-1)
    o = jnp.einsum('bhsm,bmhd->bshd', p.astype(v.dtype), v)
    return o.reshape(bsz, seq, M_WIDTH)


def setup_inputs(seed: int = 0) -> dict:
    key = jax.random.key(seed)
    ks = jax.random.split(key, 16)
    nrm = jax.random.normal
    f32 = jnp.float32
    return {
        "x": nrm(ks[0], (BATCH, SEQ, D_MODEL), f32),
        "mem": nrm(ks[1], (BATCH, MEM_LEN, D_MODEL), f32),
        "norm_g": 1.0 + 0.01 * nrm(ks[2], (DEPTH, D_MODEL), f32),
        "w_in": nrm(ks[3], (DEPTH, D_MODEL, IN_WIDTH), f32) * D_MODEL ** -0.5,
        "q_norm_g": 1.0 + 0.01 * nrm(ks[4], (DEPTH, A_HEAD_DIM), f32),
        "k_norm_g": 1.0 + 0.01 * nrm(ks[5], (DEPTH, A_HEAD_DIM), f32),
        "sg_ln_g": 1.0 + 0.01 * nrm(ks[6], (DEPTH, B_WIDTH), f32),
        "sg_ln_b": 0.01 * nrm(ks[7], (DEPTH, B_WIDTH), f32),
        "w_s": nrm(ks[8], (DEPTH, B_GROUPS, CHUNK, CHUNK), f32) * CHUNK ** -0.5,
        "b_s": 1.0 + 0.01 * nrm(ks[9], (DEPTH, B_GROUPS, CHUNK), f32),
        "mem_norm_g": 1.0 + 0.01 * nrm(ks[10], (DEPTH, D_MODEL), f32),
        "w_mem_kv": nrm(ks[11], (DEPTH, D_MODEL, 2 * M_WIDTH), f32) * D_MODEL ** -0.5,
        "w_br": nrm(ks[12], (DEPTH, N_BRANCH, BRANCH_WIDTH, D_MODEL), f32) * BRANCH_WIDTH ** -0.5,
        "w_out": nrm(ks[13], (DEPTH, D_MODEL, D_MODEL), f32) * D_MODEL ** -0.5,
        "final_g": 1.0 + 0.01 * nrm(ks[14], (D_MODEL,), f32),
    }


def reference(x, mem, norm_g, w_in, q_norm_g, k_norm_g, sg_ln_g, sg_ln_b, w_s, b_s,
              mem_norm_g, w_mem_kv, w_br, w_out, final_g):
    bsz, seq, d = x.shape
    cos, sin = axial_rope_tables(seq)
    pts = _split_points()
    for l in range(DEPTH):
        h = rms_norm(x, norm_g[l])
        proj = h @ w_in[l]
        qA, kA, vA, zA, uB, vB, zB, qM, zM, g_logits = jnp.split(proj, pts, axis=-1)
        yA = gqa_axial_attention(qA, kA, vA, q_norm_g[l], k_norm_g[l], cos, sin) * jax.nn.silu(zA)
        yB = chunked_spatial_gating(uB, vB, sg_ln_g[l], sg_ln_b[l], w_s[l], b_s[l]) * jax.nn.silu(zB)
        mem_n = rms_norm(mem, mem_norm_g[l])
        yM = memory_cross_attention(qM, mem_n, w_mem_kv[l]) * jax.nn.silu(zM)
        branches = jnp.stack([yA, yB, yM], axis=2)
        up = jnp.einsum('bsnw,nwd->bsnd', branches, w_br[l])
        gates = jax.nn.sigmoid(g_logits.reshape(bsz, seq, N_BRANCH, d))
        merged = jnp.sum(gates * up, axis=2)
        x = x + merged @ w_out[l]
    return rms_norm(x, final_g)
```

```cpp
#include <hip/hip_runtime.h>
#include <hip/hip_cooperative_groups.h>
#include <hip/hip_bf16.h>
#include <cstdio>
#include <cstdint>
#include <cmath>
namespace cg = cooperative_groups;
__device__ __forceinline__ int opaque_tid() { int t = threadIdx.x; asm volatile("" : "+v"(t)); return t; }
namespace pg8 {
#define PG8_LAS __attribute__((address_space(3)))
typedef unsigned short bf16_t;
typedef short bf16x8 __attribute__((ext_vector_type(8)));
typedef float f32x4 __attribute__((ext_vector_type(4)));
typedef unsigned u32x4 __attribute__((ext_vector_type(4)));
constexpr int BM = 256, BK = 64, HALF = 128, HTB = HALF * BK * 2  , STAGE_BYTES = 8 * HTB, NXCD = 8, WGM = 8;

__host__ __device__ __forceinline__ int lds_byte(int r, int c) { const int st = (r >> 4) * 2 + (c >> 5), rr = r & 15, cc = c & 31, ob = rr * 64 + cc * 2; return st * 1024 + (ob ^ (((ob >> 9) & 1) << 5)); }
__host__ __device__ __forceinline__ void stage_rc(int b, int& R, int& C) { const int st = b / 1024, sb = b % 1024, swz = sb ^ (((sb >> 9) & 1) << 5); R = (st >> 1) * 16 + swz / 64; C = (st & 1) * 32 + (swz % 64) / 2; }
__host__ __device__ __forceinline__ int perm32(int rho) { const int n = rho >> 4, i = rho & 15; return 8 * (i >> 2) + 4 * n + (i & 3); }

struct Unit { int pm, pn; };
struct Gemm { const bf16_t* A; const bf16_t* Bt; int M, N, K; };

struct StaticOrder {
    int nM, nN, nwg, G, c;
    __host__ __device__ void init(int M, int N, int G_, int c_) { nM = M / BM; nN = N / BM; nwg = nM * nN; G = G_; c = c_; }
    __host__ __device__ bool next(int i, Unit& u) const {
        const long L = (long)i * G + c; if (L >= nwg) return false;
        int wgid = (int)L; { const int q = nwg / NXCD, r = nwg % NXCD, xcd = wgid % NXCD, off = wgid / NXCD; wgid = (xcd < r ? xcd * (q + 1) : r * (q + 1) + (xcd - r) * q) + off; }
        const int nig = WGM * nN, gid = wgid / nig, fm = gid * WGM, gsz = (nM - fm) < WGM ? (nM - fm) : WGM;
        u.pm = fm + ((wgid % nig) % gsz); u.pn = (wgid % nig) / gsz; return true;
    }
    __device__ __forceinline__ void a_ready(const Unit&) const {}
    __device__ __forceinline__ void done(const Unit&) const {}
};

__device__ __forceinline__ unsigned cvt_pk_bf16(float lo, float hi) { unsigned r; asm volatile("v_cvt_pk_bf16_f32 %0, %1, %2" : "=v"(r) : "v"(lo), "v"(hi)); return r; }
typedef float f32x2 __attribute__((ext_vector_type(2)));
__device__ __forceinline__ f32x2 gelu_pk(f32x2 v) {
    const f32x2 av = __builtin_elementwise_abs(v), d = av * 0.2316418882f + 1.0f;
    f32x2 t; t.x = __builtin_amdgcn_rcpf(d.x); t.y = __builtin_amdgcn_rcpf(d.y);
    f32x2 q = t * 0.5307027145f + (-0.7265760135f); q = q * t + 0.7107068705f; q = q * t + (-0.142248368f); q = q * t + 0.127414796f; q = q * t;
    const f32x2 s = (v * v) * (-0.72134752044f);
    f32x2 e; e.x = __builtin_amdgcn_exp2f(s.x); e.y = __builtin_amdgcn_exp2f(s.y);
    const f32x2 m = v * (q * e), r = v - m;
    f32x2 o; o.x = v.x < 0.f ? m.x : r.x; o.y = v.y < 0.f ? m.y : r.y; return o;
}

template <int ACT  > struct EpiBf16 {
    static constexpr bool PERM = true, AFTER_DRAIN = false; static_assert(ACT == 0 || ACT == 1, "EpiBf16: ACT is 0 (none) or 1 (gelu_pk)");
    bf16_t* O; int ldc; const float* bias; int split_cols; size_t split_stride; float scale0;
    __device__ __forceinline__ void operator()(const f32x4 (&acc)[2][2][4][2], const Unit& u, int wr, int wc, int fr, int fq) const {
        const int row0 = u.pm * BM + wr * 64 + fr; int colt = u.pn * BM; bf16_t* base = O;
        float sc = 1.f; if (split_cols) { const int t = colt / split_cols; base += (size_t)t * split_stride; colt -= t * split_cols; if (t == 0) sc = scale0; }
        const int col0 = colt + wc * 32 + 8 * fq, bcol0 = u.pn * BM + wc * 32 + 8 * fq;
        f32x4 bv[2][2];
#pragma unroll
        for (int bj = 0; bj < 2; ++bj)
#pragma unroll
            for (int n = 0; n < 2; ++n) bv[bj][n] = bias ? *(const f32x4*)(bias + bcol0 + bj * HALF + 4 * n) : (f32x4){0.f, 0.f, 0.f, 0.f};
#pragma unroll
        for (int ai = 0; ai < 2; ++ai)
#pragma unroll
            for (int m = 0; m < 4; ++m) { bf16_t* rowp = base + (size_t)(row0 + ai * HALF + m * 16) * ldc + col0;
#pragma unroll
                for (int bj = 0; bj < 2; ++bj) { f32x4 v0 = acc[ai][bj][m][0] + bv[bj][0], v1 = acc[ai][bj][m][1] + bv[bj][1];
                    if (ACT == 1) { f32x2 a = gelu_pk((f32x2){v0[0], v0[1]}), b = gelu_pk((f32x2){v0[2], v0[3]}), c = gelu_pk((f32x2){v1[0], v1[1]}), d = gelu_pk((f32x2){v1[2], v1[3]});
                        v0 = (f32x4){a.x, a.y, b.x, b.y}; v1 = (f32x4){c.x, c.y, d.x, d.y}; }
                    v0 = v0 * sc; v1 = v1 * sc; u32x4 w; w.x = cvt_pk_bf16(v0[0], v0[1]); w.y = cvt_pk_bf16(v0[2], v0[3]); w.z = cvt_pk_bf16(v1[0], v1[1]); w.w = cvt_pk_bf16(v1[2], v1[3]);
                    *(u32x4*)(rowp + bj * HALF) = w; } }
    }
};
}
namespace mg3 {
constexpr int BK = 64, TILE_B = 256 * 128, LDS_NEED = 4 * TILE_B;
template <class Epi, class Sched>
__device__ __forceinline__ void gemm_phase(PG8_LAS unsigned char* lds, const unsigned short* A, const unsigned short* Bt, int K, const Sched& S, const Epi& E) {
    typedef short bf16x8_ __attribute__((ext_vector_type(8)));
    typedef float f32x4_ __attribute__((ext_vector_type(4)));
    const int tid = opaque_tid(), lane = tid & 63, wid = __builtin_amdgcn_readfirstlane(tid >> 6), wm = wid >> 2, wn = wid & 3, fr = lane & 15, fq = lane >> 4;
    const int nk = K / BK;
    pg8::Unit cur, nxt;
    if (!S.next(0, cur)) return;
    const int r3 = lane >> 3, lc = (lane & 7) ^ ((4 * (wid & 1) + (lane >> 4)) & 7);
    const unsigned gofa = (unsigned)((8 * wid + r3) * K + lc * 8) * 2u;
    const unsigned gofb = (unsigned)((32 * (wid & 1) + 16 * (r3 >> 2) + 4 * (wid >> 1) + (r3 & 3)) * K + lc * 8) * 2u;
    const unsigned qstep = (unsigned)(64 * K) * 2u;
    const int sw = (fr >> 1) & 7;
    const int off0 = ((0 + fq) ^ sw) * 16, off1 = ((4 + fq) ^ sw) * 16;
    const int lra = (wm * 128 + fr) * 128, lrb = (wn * 64 + fr) * 128;
    f32x4_ acc[8][4];
#pragma unroll
    for (int m = 0; m < 8; ++m)
#pragma unroll
        for (int n = 0; n < 4; ++n) acc[m][n] = f32x4_{0.f, 0.f, 0.f, 0.f};
#define MG3_SYNC() do { asm volatile("s_waitcnt vmcnt(0)" ::: "memory"); __syncthreads(); } while (0)
#define MG3_SB() __builtin_amdgcn_sched_barrier(0)
    bool has_next = S.next(1, nxt);
    {   const char* pa_ = (const char*)(A + (size_t)cur.pm * 256 * K); const char* pb_ = (const char*)(Bt + (size_t)cur.pn * 256 * K);
#pragma unroll
        for (int q = 0; q < 4; ++q) {
            __builtin_amdgcn_global_load_lds((const unsigned*)(pa_ + (size_t)q * qstep + gofa), (PG8_LAS unsigned*)(lds + wid * 1024 + q * 8192), 16, 0, 0);
            __builtin_amdgcn_global_load_lds((const unsigned*)(pb_ + (size_t)q * qstep + gofb), (PG8_LAS unsigned*)(lds + TILE_B + wid * 1024 + q * 8192), 16, 0, 0); } }
    MG3_SYNC();
    int buf = 0;
    for (int ui = 0;; ++ui) {
        for (int kt = 0; kt < nk; ++kt) {
            const bool dnext = (kt + 1 < nk) || has_next;
            const pg8::Unit& du = (kt + 1 < nk) ? cur : nxt; const int dkt = (kt + 1 < nk) ? kt + 1 : 0;
            const char* dpa = (const char*)(A + (size_t)du.pm * 256 * K + (size_t)dkt * BK); const char* dpb = (const char*)(Bt + (size_t)du.pn * 256 * K + (size_t)dkt * BK);
            PG8_LAS unsigned char* dla = lds + (buf ^ 1) * 2 * TILE_B + wid * 1024;
#define MG3_PA(Q) do { if (dnext) __builtin_amdgcn_global_load_lds((const unsigned*)(dpa + (size_t)(Q) * qstep + gofa), (PG8_LAS unsigned*)(dla + (Q) * 8192), 16, 0, 0); } while (0)
#define MG3_PB(Q) do { if (dnext) __builtin_amdgcn_global_load_lds((const unsigned*)(dpb + (size_t)(Q) * qstep + gofb), (PG8_LAS unsigned*)(dla + TILE_B + (Q) * 8192), 16, 0, 0); } while (0)
            const PG8_LAS unsigned char* la = lds + buf * 2 * TILE_B + lra; const PG8_LAS unsigned char* lb = lds + buf * 2 * TILE_B + TILE_B + lrb;
            bf16x8_ a0[8], b0[4], a1[8], b1[4];
#define MG3_RD(AF, BF, OFF) do { _Pragma("unroll") for (int n = 0; n < 4; ++n) BF[n] = *(const PG8_LAS bf16x8_*)(lb + n * 2048 + (OFF)); \
                _Pragma("unroll") for (int m = 0; m < 8; ++m) AF[m] = *(const PG8_LAS bf16x8_*)(la + m * 2048 + (OFF)); } while (0)
#define MG3_M4(AF, BF, M) do { _Pragma("unroll") for (int n = 0; n < 4; ++n) acc[M][n] = __builtin_amdgcn_mfma_f32_16x16x32_bf16(BF[n], AF[M], acc[M][n], 0, 0, 0); } while (0)
            MG3_RD(a0, b0, off0); MG3_SB();
            MG3_M4(a0, b0, 0); MG3_PA(0); MG3_PB(0); MG3_SB(); MG3_M4(a0, b0, 1); MG3_PA(1); MG3_PB(1); MG3_SB();
            MG3_RD(a1, b1, off1); MG3_SB();
            MG3_M4(a0, b0, 2); MG3_PA(2); MG3_PB(2); MG3_SB(); MG3_M4(a0, b0, 3); MG3_PA(3); MG3_PB(3); MG3_SB();
            MG3_M4(a0, b0, 4); MG3_M4(a0, b0, 5); MG3_M4(a0, b0, 6); MG3_M4(a0, b0, 7); MG3_SB();
            MG3_M4(a1, b1, 0); MG3_M4(a1, b1, 1); MG3_M4(a1, b1, 2); MG3_M4(a1, b1, 3); MG3_M4(a1, b1, 4); MG3_M4(a1, b1, 5); MG3_M4(a1, b1, 6);
            MG3_SB();
            MG3_SYNC();
            MG3_SB();
            MG3_M4(a1, b1, 7);
#undef MG3_RD
#undef MG3_M4
#undef MG3_PA
#undef MG3_PB
            buf ^= 1;
        }
        bool keep_acc = false;
        { const int t2_ = opaque_tid(); const int fre = t2_ & 15, fqe = (t2_ >> 4) & 3; keep_acc = E(acc, cur, wm, wn, fre, fqe); }
        if (!has_next) break;
        if (!keep_acc) {
#pragma unroll
            for (int m = 0; m < 8; ++m)
#pragma unroll
                for (int n = 0; n < 4; ++n) acc[m][n] = f32x4_{0.f, 0.f, 0.f, 0.f}; }
        cur = nxt;
        has_next = S.next(ui + 2, nxt);
    }
#undef MG3_SYNC
#undef MG3_SB
}
}
namespace attn_body {
using bf16=__hip_bfloat16;
using bf16x8=__attribute__((ext_vector_type(8)))short;
using s16x4=__attribute__((ext_vector_type(4)))short;
using f32x16=__attribute__((ext_vector_type(16)))float;
using u32x4=__attribute__((ext_vector_type(4)))unsigned;
constexpr int SEQ=4096,D=64,QP=3840,KP=64,OP=512;
constexpr int NW=8,QBLK=32,QB=QBLK*NW,KVBLK=64,NQB=SEQ/QB;
__device__ __forceinline__ int crow(int r,int hi){return (r&3)+8*(r>>2)+4*hi;}
#define SBAR() __builtin_amdgcn_sched_barrier(0)
constexpr int NSLOT=3, SLOTB=8192;
constexpr int LDS_K=0, LDS_V=NSLOT*SLOTB, LDS_WS=2*NSLOT*SLOTB, LDS_OST=LDS_WS+NW*64*4, LDS_BYTES=LDS_OST+NW*4096;
constexpr float C2=0.125f*1.4426950408889634f;
__device__ __forceinline__ void glds16(const void*gsrc,unsigned lds_dst){unsigned keep;
  asm volatile("s_mov_b32 %0, m0\n\ts_mov_b32 m0, %2\n\ts_nop 0\n\tglobal_load_lds_dwordx4 %1, off\n\ts_mov_b32 m0, %0":"=&s"(keep):"v"(gsrc),"s"(lds_dst):"memory");}
__device__ __forceinline__ float max3f(float a,float b,float c){float r;asm("v_max3_f32 %0, %1, %2, %3":"=v"(r):"v"(a),"v"(b),"v"(c));return r;}
__device__ __forceinline__ float max2f(float a,float b){float r;asm("v_max_f32_e32 %0, %1, %2":"=v"(r):"v"(a),"v"(b));return r;}
__device__ __forceinline__ float fadd_s(float a,float b){float r;asm("v_add_f32_e32 %0, %1, %2":"=v"(r):"v"(a),"v"(b));return r;}
__device__ __forceinline__ float fsub_s(float a,float b){float r;asm("v_sub_f32_e32 %0, %1, %2":"=v"(r):"v"(a),"v"(b));return r;}
typedef float f32x2_t __attribute__((ext_vector_type(2))); typedef __bf16 bf16x2_t __attribute__((ext_vector_type(2)));
__device__ __forceinline__ unsigned cvtpk_s(float lo,float hi){f32x2_t v={lo,hi};bf16x2_t b=__builtin_convertvector(v,bf16x2_t);return __builtin_bit_cast(unsigned,b);}
#define WAIT_BAR(N) asm volatile("s_waitcnt vmcnt(" #N ") lgkmcnt(0)\n\ts_barrier":::"memory")

__device__ __forceinline__ void qkt(f32x16&p0,f32x16&p1,const char*Kslot,const bf16x8*qr,const f32x16&negm,int r32,int hi){
  const char*kb=Kslot+hi*1024+r32*16;
  #pragma unroll
  for(int d0=0;d0<4;++d0){
    const bf16x8 b0=*reinterpret_cast<const bf16x8*>(kb+d0*2048);
    const bf16x8 b1=*reinterpret_cast<const bf16x8*>(kb+d0*2048+512);
    if(d0==0){p0=__builtin_amdgcn_mfma_f32_32x32x16_bf16(b0,qr[0],negm,0,0,0);p1=__builtin_amdgcn_mfma_f32_32x32x16_bf16(b1,qr[0],negm,0,0,0);}
    else{p0=__builtin_amdgcn_mfma_f32_32x32x16_bf16(b0,qr[d0],p0,0,0,0);p1=__builtin_amdgcn_mfma_f32_32x32x16_bf16(b1,qr[d0],p1,0,0,0);}}
}
typedef __attribute__((address_space(3))) const char* lds_cptr;
typedef short v4i16_t __attribute__((ext_vector_type(4)));
__device__ __forceinline__ void kload8(bf16x8*kf,lds_cptr kp){
  kf[0]=*(const __attribute__((address_space(3))) bf16x8*)(kp);      kf[1]=*(const __attribute__((address_space(3))) bf16x8*)(kp+512);
  kf[2]=*(const __attribute__((address_space(3))) bf16x8*)(kp+2048); kf[3]=*(const __attribute__((address_space(3))) bf16x8*)(kp+2560);
  kf[4]=*(const __attribute__((address_space(3))) bf16x8*)(kp+4096); kf[5]=*(const __attribute__((address_space(3))) bf16x8*)(kp+4608);
  kf[6]=*(const __attribute__((address_space(3))) bf16x8*)(kp+6144); kf[7]=*(const __attribute__((address_space(3))) bf16x8*)(kp+6656);
}
__device__ __forceinline__ void kload2(bf16x8*kf,lds_cptr kp,int j){ kf[2*j]=*(const __attribute__((address_space(3))) bf16x8*)(kp+j*2048); kf[2*j+1]=*(const __attribute__((address_space(3))) bf16x8*)(kp+j*2048+512); }
__device__ __forceinline__ s16x4 vtr(lds_cptr p){ return __builtin_bit_cast(s16x4,__builtin_amdgcn_ds_read_tr16_b64_v4i16((__attribute__((address_space(3))) v4i16_t*)p)); }
__device__ __forceinline__ float rowmax(const f32x16&p0,const f32x16&p1){
  float a=max3f(p0[0],p0[1],p1[0]),b=max3f(p0[2],p0[3],p1[1]);a=max3f(a,p1[2],p1[3]);
  #pragma unroll
  for(int r=4;r<16;r+=4){a=max3f(a,p0[r],p0[r+1]);b=max3f(b,p0[r+2],p0[r+3]);a=max3f(a,p1[r],p1[r+1]);b=max3f(b,p1[r+2],p1[r+3]);}
  const float m=max2f(a,b);
  auto rr=__builtin_amdgcn_permlane32_swap(__float_as_uint(m),__float_as_uint(m),false,false);
  return max2f(__uint_as_float(rr[0]),__uint_as_float(rr[1]));
}
__device__ __forceinline__ void pv(f32x16*o,int vb,bf16x8 pa0,bf16x8 pa1,bf16x8 pa2,bf16x8 pa3){
  #pragma unroll
  for(int d0=0;d0<2;++d0){s16x4 lo[4],hi[4];
    #pragma unroll
    for(int ks=0;ks<4;++ks){
      asm volatile("ds_read_b64_tr_b16 %0,%1 offset:%c2":"=&v"(lo[ks]):"v"(vb),"i"(d0*4096+ks*1024):"memory");
      asm volatile("ds_read_b64_tr_b16 %0,%1 offset:%c2":"=&v"(hi[ks]):"v"(vb),"i"(d0*4096+ks*1024+512):"memory");}
    asm volatile("s_waitcnt lgkmcnt(0)":::"memory");SBAR();
    #define PK(k) (bf16x8){lo[k][0],lo[k][1],lo[k][2],lo[k][3],hi[k][0],hi[k][1],hi[k][2],hi[k][3]}
    o[d0]=__builtin_amdgcn_mfma_f32_32x32x16_bf16(pa0,PK(0),o[d0],0,0,0);
    o[d0]=__builtin_amdgcn_mfma_f32_32x32x16_bf16(pa1,PK(1),o[d0],0,0,0);
    o[d0]=__builtin_amdgcn_mfma_f32_32x32x16_bf16(pa2,PK(2),o[d0],0,0,0);
    o[d0]=__builtin_amdgcn_mfma_f32_32x32x16_bf16(pa3,PK(3),o[d0],0,0,0);
    #undef PK
  }
}

#ifndef ATTN_STORE16
#define ATTN_STORE16(p,v) (*(u32x4*)(p)=(v))
#endif
template<int THRL> __device__ __forceinline__ void attn_unit(int b,int h,int qb,const bf16*Q,const bf16*__restrict__ K,const bf16*__restrict__ V,const bf16*Z,bf16*O,char*shm){
  const int tid=opaque_tid(),lane=tid&63,r32=lane&31,hi=lane>>5; const int wid=__builtin_amdgcn_readfirstlane(tid>>6);
  const long rowbase=(long)b*SEQ; const int q0=qb*QB;
  const bf16*Qw=Q+(rowbase+q0+wid*QBLK)*QP+h*D;
  const long kvbase=((long)b*2+(h>>2))*SEQ*KP; const bf16*Kh=K+kvbase,*Vh=V+kvbase;
  const unsigned lds0=(unsigned)(uintptr_t)shm;
  float*wsf=(float*)(shm+LDS_WS)+wid*64;
  const bf16*ksrc=Kh+(long)lane*KP+wid*8;
  const bf16*vsrc=Vh+(long)(16*(wid&3)+(lane>>2))*KP+(wid>>2)*32+(lane&3)*8;
  const unsigned kdst=lds0+LDS_K+wid*1024, vdst=lds0+LDS_V+wid*1024;
  #define DMA_K(t,slot) glds16(ksrc+(long)(t)*KVBLK*KP,(unsigned)__builtin_amdgcn_readfirstlane(kdst+(slot)))
  #define DMA_V(t,slot) glds16(vsrc+(long)(t)*KVBLK*KP,(unsigned)__builtin_amdgcn_readfirstlane(vdst+(slot)))
  const int vb0=(int)(lds0+LDS_V)+((lane>>4)&1)*32+(lane&3)*8+(4*hi+((lane&15)>>2))*64;
  const char*Kbase=shm+LDS_K; bf16x8 kf[8];
  const lds_cptr shm3=(lds_cptr)shm; const lds_cptr kp0=shm3+LDS_K+hi*1024+r32*16; const lds_cptr vp0=shm3+LDS_V+((lane>>4)&1)*32+(lane&3)*8+(4*hi+((lane&15)>>2))*64;
  const int NT=SEQ/KVBLK;
  DMA_K(0,0);DMA_V(0,0);DMA_K(1,SLOTB);
  bf16x8 qr[4];
  #pragma unroll
  for(int d0=0;d0<4;++d0)qr[d0]=*reinterpret_cast<const bf16x8*>(&Qw[(long)r32*QP+d0*16+hi*8]);
  float mhat=0.f,l_reg=0.f;f32x16 o[2];o[0]=f32x16{};o[1]=f32x16{};f32x16 negm=f32x16{};asm volatile("":"+v"(negm));
  #define CMASK(P0,P1,t) do{}while(0)
  bool resc=false;
  #define START(P0,P1) do{ const float rm=rowmax(P0,P1); resc=false; \
    { const float dl=rm; mhat=fadd_s(mhat,dl); \
      _Pragma("unroll") for(int r=0;r<16;++r){P0[r]=fsub_s(P0[r],dl);P1[r]=fsub_s(P1[r],dl);} \
      _Pragma("unroll") for(int r=0;r<16;++r)negm[r]=-mhat; asm volatile("":"+v"(negm)); } \
    _Pragma("unroll") for(int r=0;r<16;++r)P0[r]=__builtin_amdgcn_exp2f(P0[r]); }while(0)
  #define RESC() do{ if(resc){ asm volatile("s_waitcnt lgkmcnt(0)":::"memory"); \
      _Pragma("unroll") for(int d_=0;d_<2;++d_) _Pragma("unroll") for(int r=0;r<16;++r)o[d_][r]*=wsf[crow(r,hi)]; } }while(0)
  f32x16 pA0,pA1,pB0,pB1;
  int sl_prev=0,sl_cur=0,sl_next=SLOTB;
  #define ROT() do{sl_prev=sl_cur;sl_cur=sl_next;sl_next=(sl_next==(NSLOT-1)*SLOTB)?0:sl_next+SLOTB;}while(0)
  DMA_K(2,2*SLOTB);
  WAIT_BAR(3);
  qkt(pA0,pA1,Kbase,qr,negm,r32,hi);asm volatile("s_nop 15\n\ts_nop 7":"+v"(pA0),"+v"(pA1));CMASK(pA0,pA1,0);
  START(pA0,pA1);
  _Pragma("unroll") for(int r=0;r<16;++r)pA1[r]=__builtin_amdgcn_exp2f(pA1[r]);
  WAIT_BAR(0);
  DMA_K(3,0);DMA_V(1,SLOTB);
  ROT();
  kload8(kf,kp0+sl_cur);
  WAIT_BAR(2);
  s16x4 vlo[8],vhi[8]; u32x4 pw0,pw1,pw2,pw3;
  #define PKW(P,B) cvtpk_s(P[B],P[B+1])
  #define PAF(k) __builtin_bit_cast(bf16x8,pw##k)
  #define VFR(i) (bf16x8){vlo[i][0],vlo[i][1],vlo[i][2],vlo[i][3],vhi[i][0],vhi[i][1],vhi[i][2],vhi[i][3]}
  #define PIN(x) asm volatile("":"+v"(x))
  #define MX3(a,b,c) __builtin_fmaxf(__builtin_fmaxf((a),(b)),(c))
  #define GAPA(MF,A0,A1,A2,A3,W0,W1,PW) do{ MF; sacc+=A0; sacc+=A1; sacc+=A2; sacc+=A3; PIN(sacc); W0; W1; PIN(PW); SBAR(); }while(0)
  #define EX(v) __builtin_amdgcn_exp2f(v)
  #define GAPB(MF,X,B) do{ MF; X[B]=EX(X[B]); X[B+1]=EX(X[B+1]); X[B+2]=EX(X[B+2]); X[B+3]=EX(X[B+3]); PIN(X); SBAR(); }while(0)
  #define VRD(i) do{ vlo[i]=vtr(vp_+(((i)>>2)*4096+((i)&3)*1024)); vhi[i]=vtr(vp_+(((i)>>2)*4096+((i)&3)*1024+512)); }while(0)
  #define KRD(G,j) do{ if(G){ kload2(kf,kp0+sl_next,j); SBAR(); } }while(0)
  #define STEP(C0,C1,P0,P1,t,GK,GV,GL) do{ SBAR(); \
    const lds_cptr vp_=vp0+sl_prev; \
    VRD(0); SBAR(); float sacc=(P0[0]+P0[1]); \
    GAPA(C0=__builtin_amdgcn_mfma_f32_32x32x16_bf16(kf[0],qr[0],negm,0,0,0), P0[2],P0[3],P0[4],P0[5],     pw0[0]=PKW(P0,0), pw0[1]=PKW(P0,2), pw0); \
    VRD(4); SBAR(); GAPA(C1=__builtin_amdgcn_mfma_f32_32x32x16_bf16(kf[1],qr[0],negm,0,0,0), P0[6],P0[7],P0[8],P0[9],     pw0[2]=PKW(P0,4), pw0[3]=PKW(P0,6), pw0); \
    VRD(1); SBAR(); GAPA(C0=__builtin_amdgcn_mfma_f32_32x32x16_bf16(kf[2],qr[1],C0,0,0,0),   P0[10],P0[11],P0[12],P0[13], pw1[0]=PKW(P0,8), pw1[1]=PKW(P0,10), pw1); \
    VRD(5); SBAR(); GAPA(C1=__builtin_amdgcn_mfma_f32_32x32x16_bf16(kf[3],qr[1],C1,0,0,0),   P0[14],P0[15],P1[0],P1[1],   pw1[2]=PKW(P0,12),pw1[3]=PKW(P0,14), pw1); \
    VRD(2); SBAR(); GAPA(C0=__builtin_amdgcn_mfma_f32_32x32x16_bf16(kf[4],qr[2],C0,0,0,0),   P1[2],P1[3],P1[4],P1[5],     pw2[0]=PKW(P1,0), pw2[1]=PKW(P1,2), pw2); \
    VRD(6); SBAR(); GAPA(C1=__builtin_amdgcn_mfma_f32_32x32x16_bf16(kf[5],qr[2],C1,0,0,0),   P1[6],P1[7],P1[8],P1[9],     pw2[2]=PKW(P1,4), pw2[3]=PKW(P1,6), pw2); \
    VRD(3); SBAR(); GAPA(C0=__builtin_amdgcn_mfma_f32_32x32x16_bf16(kf[6],qr[3],C0,0,0,0),   P1[10],P1[11],P1[12],P1[13], pw3[0]=PKW(P1,8), pw3[1]=PKW(P1,10), pw3); \
    VRD(7); SBAR(); GAPA(C1=__builtin_amdgcn_mfma_f32_32x32x16_bf16(kf[7],qr[3],C1,0,0,0),   P1[14],P1[15],0.f,0.f,       pw3[2]=PKW(P1,12),pw3[3]=PKW(P1,14), pw3); \
    l_reg+=sacc; \
    if(GK){DMA_K((t)+3,sl_cur);} if(GV){DMA_V((t)+1,sl_next);} \
    CMASK(C0,C1,t); \
    { float a=MX3(C0[0],C0[1],C1[0]),b=MX3(C0[2],C0[3],C1[1]); a=MX3(a,C1[2],C1[3]); \
      _Pragma("unroll") for(int r=4;r<16;r+=4){a=MX3(a,C0[r],C0[r+1]);b=MX3(b,C0[r+2],C0[r+3]);a=MX3(a,C1[r],C1[r+1]);b=MX3(b,C1[r+2],C1[r+3]);} \
      float rm=__builtin_fmaxf(a,b); { auto rr=__builtin_amdgcn_permlane32_swap(__float_as_uint(rm),__float_as_uint(rm),false,false); rm=__builtin_fmaxf(__uint_as_float(rr[0]),__uint_as_float(rr[1])); } \
      resc=false; \
      if(__builtin_expect(__any(rm>(float)THRL),0)){ const float dl=__builtin_fmaxf(rm,0.f); mhat+=dl; \
        _Pragma("unroll") for(int r=0;r<16;++r){C0[r]-=dl;C1[r]-=dl;} \
        _Pragma("unroll") for(int r=0;r<16;++r)negm[r]=-mhat; asm volatile("":"+v"(negm)); \
        const float f=__builtin_amdgcn_exp2f(-dl); l_reg*=f; if(hi==0)wsf[r32]=f; resc=true; } } \
    SBAR(); \
    GAPB(o[0]=__builtin_amdgcn_mfma_f32_32x32x16_bf16(PAF(0),VFR(0),o[0],0,0,0), C0,0); \
    GAPB(o[1]=__builtin_amdgcn_mfma_f32_32x32x16_bf16(PAF(0),VFR(4),o[1],0,0,0), C0,4); \
    KRD(GL,0); GAPB(o[0]=__builtin_amdgcn_mfma_f32_32x32x16_bf16(PAF(1),VFR(1),o[0],0,0,0), C0,8); \
    KRD(GL,1); GAPB(o[1]=__builtin_amdgcn_mfma_f32_32x32x16_bf16(PAF(1),VFR(5),o[1],0,0,0), C0,12); \
    KRD(GL,2); GAPB(o[0]=__builtin_amdgcn_mfma_f32_32x32x16_bf16(PAF(2),VFR(2),o[0],0,0,0), C1,0); \
    KRD(GL,3); GAPB(o[1]=__builtin_amdgcn_mfma_f32_32x32x16_bf16(PAF(2),VFR(6),o[1],0,0,0), C1,4); \
    GAPB(o[0]=__builtin_amdgcn_mfma_f32_32x32x16_bf16(PAF(3),VFR(3),o[0],0,0,0), C1,8); \
    GAPB(o[1]=__builtin_amdgcn_mfma_f32_32x32x16_bf16(PAF(3),VFR(7),o[1],0,0,0), C1,12); \
    }while(0)
  int t=1;
  #undef CMASK
  #define CMASK(P0,P1,t) do{}while(0)
  for(;t+5<NT;t+=2){
    STEP(pB0,pB1,pA0,pA1,t,true,true,true);     WAIT_BAR(2); RESC(); ROT();
    STEP(pA0,pA1,pB0,pB1,t+1,true,true,true);   WAIT_BAR(2); RESC(); ROT();
  }
  #undef CMASK
  #define CMASK(P0,P1,t) do{}while(0)
  #define ENDW(tt) do{ if((tt)+3<NT){WAIT_BAR(2);} else if((tt)+2<NT){WAIT_BAR(1);} else {WAIT_BAR(0);} }while(0)
  for(;t+1<NT;t+=2){
    STEP(pB0,pB1,pA0,pA1,t,(t+3<NT),(t+1<NT),(t+1<NT));       ENDW(t);   RESC(); ROT();
    STEP(pA0,pA1,pB0,pB1,t+1,(t+4<NT),(t+2<NT),(t+2<NT));     ENDW(t+1); RESC(); ROT();
  }
  STEP(pB0,pB1,pA0,pA1,NT-1,false,false,false); RESC();
  { float sacc=pB0[0]+pB0[1]; _Pragma("unroll") for(int r=2;r<16;++r)sacc+=pB0[r]; _Pragma("unroll") for(int r=0;r<16;++r)sacc+=pB1[r]; l_reg+=sacc;
    pw0=(u32x4){PKW(pB0,0),PKW(pB0,2),PKW(pB0,4),PKW(pB0,6)};pw1=(u32x4){PKW(pB0,8),PKW(pB0,10),PKW(pB0,12),PKW(pB0,14)};pw2=(u32x4){PKW(pB1,0),PKW(pB1,2),PKW(pB1,4),PKW(pB1,6)};pw3=(u32x4){PKW(pB1,8),PKW(pB1,10),PKW(pB1,12),PKW(pB1,14)};
    SBAR(); pv(o,vb0+sl_cur,PAF(0),PAF(1),PAF(2),PAF(3)); }
  #undef PKW
  #undef PAF
  #undef VFR
  #undef PIN
  #undef MX3
  #undef GAPA
  #undef GAPB
  #undef EX
  #undef VRD
  #undef KRD
  #undef STEP
  #undef ENDW
  {auto rr=__builtin_amdgcn_permlane32_swap(__float_as_uint(l_reg),__float_as_uint(l_reg),false,false);l_reg=__uint_as_float(rr[0])+__uint_as_float(rr[1]);}
  if(hi==0)wsf[32+r32]=l_reg;asm volatile("s_waitcnt lgkmcnt(0)":::"memory");
  const bf16*Zw0=Z+(rowbase+q0+wid*QBLK)*QP+h*D; u32x4 zz[4];
  #pragma unroll
  for(int i=0;i<4;++i){const int row=i*8+(lane>>3),ch=lane&7; zz[i]=*(const u32x4*)(Zw0+(long)row*QP+ch*8);}
  float rli[16];
  #pragma unroll
  for(int r=0;r<16;++r)rli[r]=__builtin_amdgcn_rcpf(wsf[32+crow(r,hi)]);
  bf16*Ow=O+(rowbase+q0+wid*QBLK)*OP+h*D; const bf16*Zw=Z+(rowbase+q0+wid*QBLK)*QP+h*D;
  { bf16*stg=(bf16*)(shm+LDS_OST)+wid*2048;
    #pragma unroll
    for(int r=0;r<16;++r){const int orow=crow(r,hi);
      #pragma unroll
      for(int d0=0;d0<2;++d0)stg[orow*64+d0*32+r32]=__float2bfloat16(o[d0][r]*rli[r]);}
    asm volatile("s_waitcnt lgkmcnt(0)":::"memory");
    #pragma unroll
    for(int i=0;i<4;++i){const int row=i*8+(lane>>3),ch=lane&7; u32x4 v=*(const u32x4*)(stg+row*64+ch*8); const u32x4 z=zz[i];
      #pragma unroll
      for(int e=0;e<4;++e){ v[e]=cvtpk_s(__uint_as_float(v[e]<<16)*__uint_as_float(z[e]<<16), __uint_as_float(v[e]&0xffff0000u)*__uint_as_float(z[e]&0xffff0000u)); }
      ATTN_STORE16(Ow+(long)row*OP+ch*8,v);} }
  asm volatile("s_waitcnt lgkmcnt(0)\n\ts_barrier":::"memory");
  #undef DMA_K
  #undef DMA_V
  #undef CMASK
  #undef START
  #undef RESC
  #undef ROT
}
constexpr int ATTN_LDS_BYTES=LDS_BYTES;
#undef SBAR
#undef WAIT_BAR
}
#define GAS __attribute__((address_space(1)))
#define LAS __attribute__((address_space(3)))
typedef unsigned short bf16;
typedef unsigned v4u __attribute__((ext_vector_type(4)));
typedef unsigned v2u __attribute__((ext_vector_type(2)));
typedef float f32x4 __attribute__((ext_vector_type(4)));
typedef float f32x16 __attribute__((ext_vector_type(16)));
typedef short bf16x8 __attribute__((ext_vector_type(8)));
typedef short s16x4 __attribute__((ext_vector_type(4)));

constexpr int NWAVES = 8;
constexpr int DMOD = 1024, BATCH = 8, SEQ = 4096, DEPTH = 4, M_TOT = BATCH * SEQ;
constexpr int NCHUNK = 2, BC = BATCH / NCHUNK, MC = BC * SEQ;
constexpr int INW = 6912, PP = 3840;
constexpr int C_QA = 0, C_KA = 512, C_VA = 640, C_ZA = 768, C_UB = 1280, C_VB = 1792, C_ZB = 2304, C_QM = 2816, C_ZM = 3328, C_G = 3840;
constexpr int MEML = 256;
constexpr float EPS = 1e-6f;
constexpr float L2E = 1.4426950408889634f;
constexpr float QSCALE_A = 0.125f * L2E;
constexpr float SC_M = 0.08838834764831845f * L2E;

constexpr size_t MiB = 1u << 20;
constexpr size_t WS_TAB = 0;
constexpr size_t WS_BAR = 512 * 1024, WS_BAR_BYTES = 16384;
constexpr size_t WS_WIN = 1 * MiB;
constexpr size_t WS_WBR = 55 * MiB;
constexpr size_t WS_WOUT = 67 * MiB;
constexpr size_t WS_WKV = 75 * MiB;
constexpr size_t WS_WSB = 83 * MiB;
constexpr size_t WS_MEMN = 84 * MiB;
constexpr size_t WS_KM = 100 * MiB;
constexpr size_t WS_VMT = 108 * MiB;
constexpr size_t WS_H = 116 * MiB;
constexpr size_t WS_Y = 148 * MiB;
constexpr size_t WS_KD = 196 * MiB;
constexpr size_t WS_VD = 200 * MiB;
constexpr size_t WS_XB = 204 * MiB;
constexpr size_t WS_LNP = 242 * MiB;
constexpr size_t WS_SS = 240 * MiB;
constexpr size_t WS_G8 = 388 * MiB;
constexpr size_t WS_P = 268 * MiB;
constexpr size_t WS_END = 484 * MiB;
static_assert(WS_P + (size_t)MC * PP * 2 <= WS_G8 && WS_G8 + (size_t)MC * 3072 <= WS_END, "ws map");

#ifndef USE_MG
#define GEMM_NS mg3
#define GEMM_LDS ldsl
#else
#define GEMM_NS mg
#define GEMM_LDS lds
#endif
constexpr int RST_OFF = 147456, LDS_BYTES = 147456 + 7 * 1024 + 256;
#ifndef P2_ALIGN
#define P2_ALIGN true
#endif
#ifndef P2_SP2
#define P2_SP2 true
#endif
#ifndef REP_P6
#define REP_P6 1
#endif
#ifndef REP_P2
#define REP_P2 1
#endif
#ifndef REP_ATT
#define REP_ATT 1
#endif
#ifndef REP_P5
#define REP_P5 1
#endif
#ifndef REP_M
#define REP_M 1
#endif
#ifndef REP_B
#define REP_B 1
#endif
#ifndef PHM
#define PHM 0xffff
#endif

__device__ __forceinline__ unsigned f2bf(float f) { unsigned u = __builtin_bit_cast(unsigned, f); return (u + 0x7fffu + ((u >> 16) & 1u)) >> 16; }
__device__ __forceinline__ unsigned pk2(float lo, float hi) { return f2bf(lo) | (f2bf(hi) << 16); }
__device__ __forceinline__ float bflo(unsigned u) { return __uint_as_float(u << 16); }
__device__ __forceinline__ float bfhi(unsigned u) { return __uint_as_float(u & 0xffff0000u); }
__device__ __forceinline__ float bf1(bf16 u) { return __uint_as_float((unsigned)u << 16); }
template <int M> __device__ __forceinline__ float swz_xor(float v) { return __builtin_bit_cast(float, __builtin_amdgcn_ds_swizzle(__builtin_bit_cast(int, v), (M << 10) | 0x1f)); }
__device__ __forceinline__ float half_sum(float v) { auto rr = __builtin_amdgcn_permlane32_swap(__float_as_uint(v), __float_as_uint(v), false, false); return __uint_as_float(rr[0]) + __uint_as_float(rr[1]); }
__device__ __forceinline__ float half_max(float v) { auto rr = __builtin_amdgcn_permlane32_swap(__float_as_uint(v), __float_as_uint(v), false, false); return fmaxf(__uint_as_float(rr[0]), __uint_as_float(rr[1])); }
__device__ __forceinline__ float wave_sum(float v) {
    v += swz_xor<1>(v); v += swz_xor<2>(v); v += swz_xor<4>(v); v += swz_xor<8>(v); v += swz_xor<16>(v);
    return half_sum(v);
}
#define LDS_WAIT() asm volatile("s_waitcnt lgkmcnt(0)" ::: "memory")

#define XB_TMO      128
#define XB_XCNT(j)  (256  + 64 * (j))
#define XB_XSUB(j)  (1280 + 64 * (j))
#define XB_XGEN(j)  (2304 + 64 * (j))
#define XB_TOP      3328
#define XB_TOPGEN   3392
#define XCD_BAR_WORDS 3456
#define XB_SPIN_CAP (1u << 18)

__device__ __forceinline__ unsigned xb_ld(unsigned* p)              { return __hip_atomic_load(p, __ATOMIC_RELAXED, __HIP_MEMORY_SCOPE_AGENT); }
__device__ __forceinline__ unsigned xb_add(unsigned* p, unsigned v) { return __hip_atomic_fetch_add(p, v, __ATOMIC_RELAXED, __HIP_MEMORY_SCOPE_AGENT); }
__device__ __forceinline__ unsigned xb_xcc_id() { return (unsigned)__builtin_amdgcn_s_getreg((3 << 11) | 20) & 0xFu; }
#define XB_SPIN(cond, bar) do { unsigned _sp = 0; while (cond) { __builtin_amdgcn_s_sleep(1); \
    if ((++_sp & 255u) == 0u) { if (xb_ld(&(bar)[XB_TMO])) break; if (_sp > XB_SPIN_CAP) { atomicAdd(&(bar)[XB_TMO], 1u); break; } } } } while (0)

struct XcdBarrier {
    unsigned* bar; unsigned x;
    volatile LAS unsigned* st;
};

__device__ __forceinline__ XcdBarrier xcd_barrier_post(unsigned* bar, volatile LAS unsigned* st) {
    XcdBarrier b; b.bar = bar; b.x = xb_xcc_id(); b.st = st;
    if (threadIdx.x == 0) (void)xb_add(&bar[XB_XCNT(b.x)], 1u);
    return b;
}
__device__ __forceinline__ void xcd_barrier_complete(unsigned* bar, unsigned x, unsigned& nloc, unsigned& nx) {
    const unsigned G = gridDim.x * gridDim.y * gridDim.z;
    unsigned sum, cnt, mine, sp = 0u;
    for (;;) {
        sum = 0u; cnt = 0u; mine = 0u;
#pragma unroll
        for (unsigned j = 0; j < 16; ++j) { const unsigned c = xb_ld(&bar[XB_XCNT(j)]); sum += c; cnt += (c > 0u) ? 1u : 0u; mine = (j == x) ? c : mine; }
        if (sum == G) break;
        __builtin_amdgcn_s_sleep(1);
        if ((++sp & 255u) == 0u) { if (xb_ld(&bar[XB_TMO])) break; if (sp > XB_SPIN_CAP) { atomicAdd(&bar[XB_TMO], 1u); break; } }
    }
    nloc = mine > 0u ? mine : 1u; nx = cnt > 0u ? cnt : 1u;
}

__device__ __forceinline__ void xcd_barrier(const XcdBarrier& b) {
    asm volatile("s_waitcnt vmcnt(0)" ::: "memory");
    __syncthreads();
    if (threadIdx.x == 0) {
        unsigned* bar = b.bar;
        __builtin_amdgcn_s_waitcnt(0);
        unsigned nloc = b.st[0], nx = b.st[1];
        if (nloc == 0u) { xcd_barrier_complete(bar, b.x, nloc, nx); b.st[0] = nloc; b.st[1] = nx; }
        const unsigned old = xb_add(&bar[XB_XSUB(b.x)], 1u);
        const unsigned gen = old / nloc;
        if (old + 1u == (gen + 1u) * nloc) {
            __builtin_amdgcn_fence(__ATOMIC_RELEASE, "agent");
            asm volatile("s_waitcnt vmcnt(0)" ::: "memory");
            const unsigned og = xb_add(&bar[XB_TOP], 1u);
            const unsigned tg = og / nx;
            if (og + 1u == (tg + 1u) * nx) xb_add(&bar[XB_TOPGEN], 1u);
            else XB_SPIN(xb_ld(&bar[XB_TOPGEN]) == tg, bar);
            __builtin_amdgcn_fence(__ATOMIC_ACQUIRE, "agent");
            xb_add(&bar[XB_XGEN(b.x)], 1u);
            asm volatile("s_waitcnt vmcnt(0)" ::: "memory");
        } else {
            XB_SPIN(xb_ld(&bar[XB_XGEN(b.x)]) == gen, bar);
            __builtin_amdgcn_fence(__ATOMIC_ACQUIRE, "agent");
            asm volatile("s_waitcnt vmcnt(0)" ::: "memory");
        }
    }
    __syncthreads();
}

struct Args {
    const float* x; const float* mem; const float* norm_g; const float* w_in; const float* q_g; const float* k_g; const float* ln_g; const float* ln_b;
    const float* w_s; const float* b_s; const float* mem_g; const float* w_kv; const float* w_br; const float* w_out; const float* final_g;
    float* out; unsigned char* ws;
};

__device__ __forceinline__ int uz_row(int c) {
    int ch, half;
    if (c >= 1280 && c < 1792) { ch = c - 1280; half = 0; } else if (c >= 2304 && c < 2816) { ch = c - 2304; half = 1; } else return c;
    const int t = ch >> 7, tile = t < 2 ? 5 + t : 7 + t;
    return tile * 256 + ((ch >> 5) & 3) * 64 + ((ch >> 3) & 3) * 16 + half * 8 + (ch & 7);
}
__device__ __forceinline__ void p0_transpose_item(const float* W, int K, int N, bf16* WT, int row_off, LAS float* scr, int item, int lane, const float* kscale = nullptr, bool uzmap = false) {
    const int nblk = N / 32, kb = item / nblk, nb = item % nblk, k0 = 64 * kb, n0 = 32 * nb;
#pragma unroll 8
    for (int i = 0; i < 32; ++i) { const int kk = 2 * i + (lane >> 5); scr[kk * 33 + (lane & 31)] = W[(size_t)(k0 + kk) * N + n0 + (lane & 31)]; }
    LDS_WAIT(); asm volatile("" ::: "memory");
    const int c = lane & 7;
    float ks[8];
#pragma unroll
    for (int e = 0; e < 8; ++e) ks[e] = kscale ? kscale[k0 + 8 * c + e] : 1.0f;
#pragma unroll
    for (int j = 0; j < 4; ++j) { const int n = (lane >> 3) + 8 * j; const LAS float* s = scr + (8 * c) * 33 + n;
        v4u o; o.x = pk2(s[0 * 33] * ks[0], s[1 * 33] * ks[1]); o.y = pk2(s[2 * 33] * ks[2], s[3 * 33] * ks[3]); o.z = pk2(s[4 * 33] * ks[4], s[5 * 33] * ks[5]); o.w = pk2(s[6 * 33] * ks[6], s[7 * 33] * ks[7]);
        *(v4u*)(WT + (size_t)(row_off + (uzmap ? uz_row(n0 + n) : n0 + n)) * K + k0 + 8 * c) = o; }
    LDS_WAIT(); asm volatile("" ::: "memory");
}
__device__ __forceinline__ void rms_row_to_bf16(const float* xrow, const float* g, bf16* orow, int lane) {
    const f32x4* xr = (const f32x4*)xrow + lane; const f32x4* gr = (const f32x4*)g + lane;
    f32x4 v[4]; float s = 0.f;
#pragma unroll
    for (int j = 0; j < 4; ++j) { v[j] = xr[64 * j]; s += (v[j].x * v[j].x + v[j].y * v[j].y) + (v[j].z * v[j].z + v[j].w * v[j].w); }
    const float r = 1.0f / sqrtf(wave_sum(s) * (1.f / DMOD) + EPS);
    v2u* o8 = (v2u*)orow + lane;
#pragma unroll
    for (int j = 0; j < 4; ++j) { const f32x4 gg = gr[64 * j]; v2u o; o.x = pk2(v[j].x * r * gg.x, v[j].y * r * gg.y); o.y = pk2(v[j].z * r * gg.z, v[j].w * r * gg.w); o8[64 * j] = o; }
}
__device__ __forceinline__ void row_to_bf16_ss(const float* xrow, bf16* orow, float* ss, int lane) {
    const f32x4* xr = (const f32x4*)xrow + lane; f32x4 v[4]; float s = 0.f;
#pragma unroll
    for (int j = 0; j < 4; ++j) { v[j] = __builtin_nontemporal_load(xr + 64 * j); s += (v[j].x * v[j].x + v[j].y * v[j].y) + (v[j].z * v[j].z + v[j].w * v[j].w); }
    s = wave_sum(s); if (lane < 16) ss[(size_t)lane * MC] = lane == 0 ? s : 0.f;
    v2u* o8 = (v2u*)orow + lane;
#pragma unroll
    for (int j = 0; j < 4; ++j) { v2u o; o.x = pk2(v[j].x, v[j].y); o.y = pk2(v[j].z, v[j].w); o8[64 * j] = o; }
}
__device__ __forceinline__ void rms_row_from_bf16(const bf16* xrow, const float* g, float* orow, int lane) {
    const v2u* xr = (const v2u*)xrow + lane; const f32x4* gr = (const f32x4*)g + lane; f32x4 v[4]; float s = 0.f;
#pragma unroll
    for (int j = 0; j < 4; ++j) { const v2u w = xr[64 * j]; v[j] = (f32x4){bflo(w.x), bfhi(w.x), bflo(w.y), bfhi(w.y)}; s += (v[j].x * v[j].x + v[j].y * v[j].y) + (v[j].z * v[j].z + v[j].w * v[j].w); }
    const float r = 1.0f / sqrtf(wave_sum(s) * (1.f / DMOD) + EPS);
    f32x4* o = (f32x4*)orow + lane;
#pragma unroll
    for (int j = 0; j < 4; ++j) { const f32x4 gg = gr[64 * j]; __builtin_nontemporal_store(v[j] * r * gg, o + 64 * j); }
}
__device__ __forceinline__ void rms_row_f32(const float* xrow, const float* g, float* orow, int lane) {
    const f32x4* xr = (const f32x4*)xrow + lane; const f32x4* gr = (const f32x4*)g + lane;
    f32x4 v[4]; float s = 0.f;
#pragma unroll
    for (int j = 0; j < 4; ++j) { v[j] = xr[64 * j]; s += (v[j].x * v[j].x + v[j].y * v[j].y) + (v[j].z * v[j].z + v[j].w * v[j].w); }
    const float r = 1.0f / sqrtf(wave_sum(s) * (1.f / DMOD) + EPS);
    f32x4* o = (f32x4*)orow + lane;
#pragma unroll
    for (int j = 0; j < 4; ++j) { const f32x4 gg = gr[64 * j]; o[64 * j] = v[j] * r * gg; }
}

struct KvOrder {
    int G, c;
    __device__ bool next(int i, pg8::Unit& u) const { const int L = i * G + c; if (L >= 128) return false; const int l = L >> 5, r = L & 31; u.pm = l * 8 + (r >> 2); u.pn = l * 4 + (r & 3); return true; }
    __device__ __forceinline__ void a_ready(const pg8::Unit&) const {}
    __device__ __forceinline__ void done(const pg8::Unit&) const {}
};
struct MergeOrder {
    int G, vcu;
    __device__ bool next(int i, pg8::Unit& u) const { const int t = vcu + G * (i / 3), n = i % 3; if (t >= (MC / 256) * 4) return false; u.pm = n * (MC / 256) + (t >> 2); u.pn = n * 4 + (t & 3); return true; }
    __device__ __forceinline__ void a_ready(const pg8::Unit&) const {}
    __device__ __forceinline__ void done(const pg8::Unit&) const {}
};

typedef f32x4 acc_t[8][4];
__device__ __forceinline__ float sigm(float v) { return __builtin_amdgcn_rcpf(1.0f + __builtin_amdgcn_exp2f(-v * L2E)); }
template <int ACT> __device__ __forceinline__ float act1(float v) { if (ACT == 0) return v; const float s = sigm(v); return ACT == 1 ? v * s : s; }
__device__ __forceinline__ v4u pack8(const float* v) { v4u w; w.x = pg8::cvt_pk_bf16(v[0], v[1]); w.y = pg8::cvt_pk_bf16(v[2], v[3]); w.z = pg8::cvt_pk_bf16(v[4], v[5]); w.w = pg8::cvt_pk_bf16(v[6], v[7]); return w; }
__device__ __forceinline__ float quad_sum(float v) { v += swz_xor<16>(v); return half_sum(v); }
struct EpiIn {
    bf16* P; const float* rst; mutable int cnt;
    bf16* Kd; bf16* Vd; const float* tab; const float* qg; const float* kg; float* lnp;
    unsigned char* G8;
    __device__ __forceinline__ void st_gate(const acc_t& acc, const pg8::Unit& u, int wm, int wn, int fr, int fq) const {
#pragma unroll
        for (int m = 0; m < 8; ++m) { const int row = u.pm * 256 + wm * 128 + 16 * m + fr; const float rs = rst[cnt * 256 + wm * 128 + 16 * m + fr];
            v4u w = {0u, 0u, 0u, 0u};
#pragma unroll
            for (int n = 0; n < 4; ++n)
#pragma unroll
                for (int e = 0; e < 4; ++e) w[n] = __builtin_amdgcn_cvt_pk_u8_f32(sigm(acc[m][n][e] * rs) * 255.0f, e, w[n]);
            *(v4u*)(G8 + (size_t)row * 3072 + (u.pn - 15) * 256 + wn * 64 + 16 * fq) = w; __builtin_amdgcn_sched_barrier(0); }
    }
    template <int ACT, bool LNST> __device__ __forceinline__ void st(const acc_t& acc, const pg8::Unit& u, int wm, int wn, int fr, int fq) const {
#pragma unroll
        for (int m = 0; m < 8; ++m) { const int row = u.pm * 256 + wm * 128 + 16 * m + fr; const float rs = rst[cnt * 256 + wm * 128 + 16 * m + fr];
            float v[16], sm = 0.f, sq = 0.f;
#pragma unroll
            for (int n = 0; n < 4; ++n)
#pragma unroll
                for (int e = 0; e < 4; ++e) { const float t = act1<ACT>(acc[m][n][e] * rs); v[4 * n + e] = t; if (LNST) { sm += t; sq += t * t; } }
            bf16* rowp = P + (size_t)row * PP + u.pn * 256 + wn * 64 + 16 * fq;
            *(v4u*)rowp = pack8(v); *(v4u*)(rowp + 8) = pack8(v + 8);
            if (LNST) { sm = quad_sum(sm); sq = quad_sum(sq); const int slot = (u.pn - 7) * 4 + wn;
                if (fq == 0) { lnp[(size_t)slot * MC + row] = sm; lnp[(size_t)(8 + slot) * MC + row] = sq; } }
            __builtin_amdgcn_sched_barrier(0); }
    }
    __device__ __forceinline__ void head_rope(const f32x4 (&a)[4], float rs, int s, const float* g, float osc, bf16* dst, int fq) const {
        float ssq = 0.f;
#pragma unroll
        for (int n = 0; n < 4; ++n)
#pragma unroll
            for (int e = 0; e < 4; ++e) { const float v = a[n][e] * rs; ssq += v * v; }
        ssq = quad_sum(ssq);
        const float rn = rs / sqrtf(ssq * (1.f / 64.f) + EPS);
        const int pos = (fq >> 1) == 0 ? (s >> 6) : (s & 63); const float* ct = tab + pos * 16; const float* gj = g + 16 * fq; const bool lo = (fq & 1) == 0;
        unsigned pk[8];
#pragma unroll
        for (int n = 0; n < 4; ++n) { const f32x4 c4 = *(const f32x4*)(ct + 4 * n), s4 = *(const f32x4*)(ct + 1024 + 4 * n), g4 = *(const f32x4*)(gj + 4 * n);
            float o[4];
#pragma unroll
            for (int e = 0; e < 4; ++e) { const float y = a[n][e] * rn * g4[e], yp = swz_xor<16>(y);
                o[e] = (lo ? y * c4[e] - yp * s4[e] : y * c4[e] + yp * s4[e]) * osc; }
            pk[2 * n] = pg8::cvt_pk_bf16(o[0], o[1]); pk[2 * n + 1] = pg8::cvt_pk_bf16(o[2], o[3]); }
        *(v4u*)dst = (v4u){pk[0], pk[1], pk[2], pk[3]}; *(v4u*)(dst + 8) = (v4u){pk[4], pk[5], pk[6], pk[7]}; __builtin_amdgcn_sched_barrier(0);
    }
    __device__ __forceinline__ void st_uz(const acc_t& acc, const pg8::Unit& u, int wm, int wn, int fr, int fq) const {
        const int t = u.pn < 7 ? u.pn - 5 : u.pn - 7;
#pragma unroll
        for (int m = 0; m < 8; ++m) { const int row = u.pm * 256 + wm * 128 + 16 * m + fr; const float rs = rst[cnt * 256 + wm * 128 + 16 * m + fr];
            float v[8];
#pragma unroll
            for (int n = 0; n < 2; ++n)
#pragma unroll
                for (int e = 0; e < 4; ++e) v[4 * n + e] = acc[m][n][e] * rs * act1<1>(acc[m][2 + n][e] * rs);
            *(v4u*)(P + (size_t)row * PP + C_UB + 128 * t + 32 * wn + 8 * fq) = pack8(v); __builtin_amdgcn_sched_barrier(0); }
    }
    __device__ __forceinline__ void st_qkv(const acc_t& acc, const pg8::Unit& u, int wm, int wn, int fr, int fq) const {
#pragma unroll
        for (int m = 0; m < 8; ++m) { const int row = u.pm * 256 + wm * 128 + 16 * m + fr, s = row & (SEQ - 1), bl = row >> 12;
            const float rs = rst[cnt * 256 + wm * 128 + 16 * m + fr];
            if (u.pn < 2) head_rope(acc[m], rs, s, qg, QSCALE_A, P + (size_t)row * PP + u.pn * 256 + wn * 64 + 16 * fq, fq);
            else if (wn < 2) head_rope(acc[m], rs, s, kg, 1.0f, Kd + ((size_t)(bl * 2 + wn) * SEQ + s) * 64 + 16 * fq, fq);
            else { bf16* dst = Vd + ((size_t)(bl * 2 + (wn - 2)) * SEQ + s) * 64 + 16 * fq; float v[16];
#pragma unroll
                for (int n = 0; n < 4; ++n)
#pragma unroll
                    for (int e = 0; e < 4; ++e) v[4 * n + e] = acc[m][n][e] * rs;
                *(v4u*)dst = pack8(v); *(v4u*)(dst + 8) = pack8(v + 8); } }
    }
    __device__ __forceinline__ bool operator()(acc_t& acc, const pg8::Unit& u, int wm, int wn, int fr, int fq) const {
        const int pn = u.pn;
        if (pn >= 15) st_gate(acc, u, wm, wn, fr, fq);
        else if (pn == 5 || pn == 6 || pn == 9 || pn == 10) st_uz(acc, u, wm, wn, fr, fq);
        else if (pn == 3 || pn == 4 || pn == 13 || pn == 14) st<1, false>(acc, u, wm, wn, fr, fq);
        else if (pn < 3) st_qkv(acc, u, wm, wn, fr, fq);
        else if (pn == 7 || pn == 8) st<0, true>(acc, u, wm, wn, fr, fq);
        else st<0, false>(acc, u, wm, wn, fr, fq);
        ++cnt;
        return false;
    }
};
struct EpiKv {
    bf16* KM; bf16* VMT;
    __device__ __forceinline__ bool operator()(acc_t& acc, const pg8::Unit& u, int wm, int wn, int fr, int fq) const {
        const int lb = u.pm, jt = u.pn & 3, h = 2 * (jt & 1) + (wn >> 1), d0 = (wn & 1) * 64 + 16 * fq;
#pragma unroll
        for (int m = 0; m < 8; ++m) { const int key = wm * 128 + 16 * m + fr; float v[16];
#pragma unroll
            for (int n = 0; n < 4; ++n)
#pragma unroll
                for (int e = 0; e < 4; ++e) v[4 * n + e] = acc[m][n][e];
            if (jt < 2) { bf16* kp = KM + ((size_t)(lb * 4 + h) * 256 + key) * 128 + d0; *(v4u*)kp = pack8(v); *(v4u*)(kp + 8) = pack8(v + 8); }
            else { bf16* vp = VMT + ((size_t)(lb * 4 + h) * 128 + d0) * 256 + key;
#pragma unroll
                for (int r = 0; r < 16; ++r) vp[r * 256] = (bf16)f2bf(v[r]); } }
        return false;
    }
};
struct EpiMerge {
    const unsigned char* G8; bf16* MG;
    __device__ __forceinline__ bool operator()(acc_t& acc, const pg8::Unit& u, int wm, int wn, int fr, int fq) const {
        const int nb = u.pn >> 2, jt = u.pn & 3, pm = u.pm - nb * (MC / 256);
        constexpr float GMIN = 5.9604645e-8f;
        const int col0 = jt * 256 + wn * 64 + 16 * fq;
#pragma unroll
        for (int m = 0; m < 8; ++m) { const size_t row = (size_t)(pm * 256 + wm * 128 + 16 * m + fr);
            const unsigned char* gp = G8 + row * 3072 + nb * 1024 + col0;
            const v4u g0 = *(const v4u*)gp;
            if (nb < 2) { const v4u h0 = *(const v4u*)(gp + 1024);
#pragma unroll
                for (int n = 0; n < 4; ++n)
#pragma unroll
                    for (int e = 0; e < 4; ++e) { const float g = (float)((g0[n] >> (8 * e)) & 255u) * (1.0f / 255.0f), gn = (float)((h0[n] >> (8 * e)) & 255u) * (1.0f / 255.0f);
                        acc[m][n][e] *= fmaxf(g, GMIN) * __builtin_amdgcn_rcpf(fmaxf(gn, GMIN)); }
            } else { float v[16];
#pragma unroll
                for (int n = 0; n < 4; ++n)
#pragma unroll
                    for (int e = 0; e < 4; ++e) v[4 * n + e] = acc[m][n][e] * fmaxf((float)((g0[n] >> (8 * e)) & 255u) * (1.0f / 255.0f), GMIN);
                *(v4u*)(MG + row * DMOD + col0) = pack8(v); *(v4u*)(MG + row * DMOD + col0 + 8) = pack8(v + 8); }
            __builtin_amdgcn_sched_barrier(0); }
        return nb < 2;
    }
};
struct EpiRes {
    bf16* xb; float* ssn; bool dry;
    __device__ __forceinline__ bool operator()(acc_t& acc, const pg8::Unit& u, int wm, int wn, int fr, int fq) const {
#pragma unroll
        for (int m = 0; m < 8; ++m) { const int row = u.pm * 256 + wm * 128 + 16 * m + fr; const size_t off = (size_t)row * DMOD + u.pn * 256 + wn * 64 + 16 * fq;
            const v4u x0 = *(const v4u*)(xb + off), x1 = *(const v4u*)(xb + off + 8);
            float sq = 0.f, v[16];
#pragma unroll
            for (int n = 0; n < 4; ++n) { const unsigned w0 = n < 2 ? x0[2 * n] : x1[2 * n - 4], w1 = n < 2 ? x0[2 * n + 1] : x1[2 * n - 3];
                v[4 * n] = bflo(w0) + acc[m][n][0]; v[4 * n + 1] = bfhi(w0) + acc[m][n][1]; v[4 * n + 2] = bflo(w1) + acc[m][n][2]; v[4 * n + 3] = bfhi(w1) + acc[m][n][3]; }
            const v4u o0 = pack8(v), o1 = pack8(v + 8);
#pragma unroll
            for (int e = 0; e < 4; ++e) { const float a0 = bflo(o0[e]), a1 = bfhi(o0[e]), b0 = bflo(o1[e]), b1 = bfhi(o1[e]); sq += (a0 * a0 + a1 * a1) + (b0 * b0 + b1 * b1); }
            if (!dry) { *(v4u*)(xb + off) = o0; *(v4u*)(xb + off + 8) = o1; }
            sq = quad_sum(sq);
            if (fq == 0 && !dry) ssn[(size_t)(u.pn * 4 + wn) * MC + row] = sq;
            __builtin_amdgcn_sched_barrier(0); }
        return false;
    }
};

__device__ __forceinline__ void prep_token(int t, bf16* P, bf16* Kd, bf16* Vd, const float* tab, const float* qg, const float* kg, const float* lng, const float* lnb, int lane) {
    bf16* prow = P + (size_t)t * PP;
    const int bl = t / SEQ, s = t % SEQ, rpos = s >> 6, cpos = s & 63;
    {
        const int hd = lane < 40 ? (lane >> 2) : 9, i = lane & 3, seg = i >> 1, fo = (i & 1) * 8;
        const int col = (hd < 8 ? hd * 64 : C_KA + (hd - 8) * 64) + seg * 32 + fo;
        const v4u a = *(const v4u*)(prow + col), b = *(const v4u*)(prow + col + 16);
        float x1[8], x2[8];
#pragma unroll
        for (int e = 0; e < 4; ++e) { x1[2 * e] = bflo(a[e]); x1[2 * e + 1] = bfhi(a[e]); x2[2 * e] = bflo(b[e]); x2[2 * e + 1] = bfhi(b[e]); }
        float ss = 0.f;
#pragma unroll
        for (int e = 0; e < 8; ++e) ss += x1[e] * x1[e] + x2[e] * x2[e];
        ss += swz_xor<1>(ss); ss += swz_xor<2>(ss);
        const float r = 1.0f / sqrtf(ss * (1.f / 64.f) + EPS);
        const float* g = (hd < 8 ? qg : kg) + seg * 32 + fo;
        const int pos = seg == 0 ? rpos : cpos;
        const float* ct = tab + pos * 16 + fo; const float* st = tab + 1024 + pos * 16 + fo;
        const float osc = hd < 8 ? QSCALE_A : 1.0f;
        float o1[8], o2[8];
#pragma unroll
        for (int e = 0; e < 8; ++e) { const float y1 = x1[e] * r * g[e], y2 = x2[e] * r * g[16 + e], c = ct[e], sn = st[e]; o1[e] = (y1 * c - y2 * sn) * osc; o2[e] = (y2 * c + y1 * sn) * osc; }
        v4u w1, w2;
#pragma unroll
        for (int e = 0; e < 4; ++e) { w1[e] = pk2(o1[2 * e], o1[2 * e + 1]); w2[e] = pk2(o2[2 * e], o2[2 * e + 1]); }
        if (lane < 32) { *(v4u*)(prow + col) = w1; *(v4u*)(prow + col + 16) = w2; }
        else if (lane < 40) { bf16* kp = Kd + ((size_t)(bl * 2 + (hd - 8)) * SEQ + s) * 64 + seg * 32 + fo; *(v4u*)kp = w1; *(v4u*)(kp + 16) = w2; }
        else if (lane < 56) { const int j = lane - 40, kvh = j >> 3, d = (j & 7) * 8; *(v4u*)(Vd + ((size_t)(bl * 2 + kvh) * SEQ + s) * 64 + d) = *(const v4u*)(prow + C_VA + j * 8); }
    }
    {
        const v4u a = *(const v4u*)(prow + C_VB + lane * 8);
        float x[8];
#pragma unroll
        for (int e = 0; e < 4; ++e) { x[2 * e] = bflo(a[e]); x[2 * e + 1] = bfhi(a[e]); }
        float sm = 0.f;
#pragma unroll
        for (int e = 0; e < 8; ++e) sm += x[e];
        const float mu = wave_sum(sm) * (1.f / 512.f); float q = 0.f;
#pragma unroll
        for (int e = 0; e < 8; ++e) { x[e] -= mu; q += x[e] * x[e]; }
        const float rstd = 1.0f / sqrtf(wave_sum(q) * (1.f / 512.f) + EPS);
        const f32x4 g0 = *(const f32x4*)(lng + lane * 8), g1 = *(const f32x4*)(lng + lane * 8 + 4), b0 = *(const f32x4*)(lnb + lane * 8), b1 = *(const f32x4*)(lnb + lane * 8 + 4);
        v4u w; w.x = pk2(x[0] * rstd * g0[0] + b0[0], x[1] * rstd * g0[1] + b0[1]); w.y = pk2(x[2] * rstd * g0[2] + b0[2], x[3] * rstd * g0[3] + b0[3]);
        w.z = pk2(x[4] * rstd * g1[0] + b1[0], x[5] * rstd * g1[1] + b1[1]); w.w = pk2(x[6] * rstd * g1[2] + b1[2], x[7] * rstd * g1[3] + b1[3]);
        *(v4u*)(prow + C_VB + lane * 8) = w;
    }
}

__device__ __forceinline__ int crow16(int r, int hi) { return (r & 3) + 8 * (r >> 2) + 4 * hi; }
constexpr int MK_STR = 272, MV_STR = 528;
constexpr int MLDS_K = 0, MLDS_V = 256 * MK_STR, MLDS_SCR = MLDS_V + 128 * MV_STR;
static_assert(MLDS_SCR + 8 * 64 * 4 <= LDS_BYTES, "m-branch lds");
__device__ __forceinline__ void mbranch_unit(int lb, int bl, int h, int tb, const bf16* P, const bf16* KM, const bf16* VMT, bf16* YM, unsigned char* lds) {
    const int tid = opaque_tid(), lane = tid & 63, r32 = lane & 31, hi = lane >> 5, wid = tid >> 6;
    const bf16* Kg = KM + (size_t)(lb * 4 + h) * 256 * 128; const bf16* Vg = VMT + (size_t)(lb * 4 + h) * 128 * 256;
#pragma unroll
    for (int it = 0; it < 8; ++it) { const int i = tid + it * 512, row = i >> 4, ch = i & 15; *(v4u*)(lds + MLDS_K + row * MK_STR + ch * 16) = *(const v4u*)(Kg + row * 128 + ch * 8); }
#pragma unroll
    for (int it = 0; it < 8; ++it) { const int i = tid + it * 512, row = i >> 5, ch = i & 31; *(v4u*)(lds + MLDS_V + row * MV_STR + ch * 16) = *(const v4u*)(Vg + row * 256 + ch * 8); }
    const size_t rowq = (size_t)bl * SEQ + tb * 256 + wid * 32;
    const bf16* qp = P + (rowq + r32) * PP + C_QM + h * 128 + hi * 8;
    bf16x8 qr[8];
#pragma unroll
    for (int d0 = 0; d0 < 8; ++d0) qr[d0] = *(const bf16x8*)(qp + d0 * 16);
    __syncthreads();
    float* scr = (float*)(lds + MLDS_SCR) + wid * 64;
    f32x16 o[4];
#pragma unroll
    for (int dt = 0; dt < 4; ++dt) o[dt] = f32x16{};
    float mrun = -1e30f, lsum = 0.f;
    const unsigned char* kbase = lds + MLDS_K + r32 * MK_STR + hi * 16;
    const unsigned char* vbase = lds + MLDS_V + r32 * MV_STR + hi * 8;
    for (int kb = 0; kb < 4; ++kb) {
        f32x16 s0 = f32x16{}, s1 = f32x16{};
#pragma unroll
        for (int d0 = 0; d0 < 8; ++d0) {
            const bf16x8 a0 = *(const bf16x8*)(kbase + (kb * 64) * MK_STR + d0 * 32), a1 = *(const bf16x8*)(kbase + (kb * 64 + 32) * MK_STR + d0 * 32);
            s0 = __builtin_amdgcn_mfma_f32_32x32x16_bf16(a0, qr[d0], s0, 0, 0, 0); s1 = __builtin_amdgcn_mfma_f32_32x32x16_bf16(a1, qr[d0], s1, 0, 0, 0);
        }
        float mx = fmaxf(s0[0], s1[0]);
#pragma unroll
        for (int r = 1; r < 16; ++r) mx = fmaxf(mx, fmaxf(s0[r], s1[r]));
        mx = half_max(mx);
        const float mnew = fmaxf(mrun, mx * SC_M);
        const float f = __builtin_amdgcn_exp2f(mrun - mnew);
        float ps = 0.f;
#pragma unroll
        for (int r = 0; r < 16; ++r) { s0[r] = __builtin_amdgcn_exp2f(s0[r] * SC_M - mnew); s1[r] = __builtin_amdgcn_exp2f(s1[r] * SC_M - mnew); ps += s0[r] + s1[r]; }
        lsum = lsum * f + ps;
        if (__any(mnew > mrun)) {
            if (hi == 0) scr[r32] = f;
            LDS_WAIT();
#pragma unroll
            for (int r = 0; r < 16; ++r) { const float fr_ = scr[crow16(r, hi)];
#pragma unroll
                for (int dt = 0; dt < 4; ++dt) o[dt][r] *= fr_; }
            LDS_WAIT();
        }
        mrun = mnew;
        bf16x8 pa[4];
#pragma unroll
        for (int g = 0; g < 4; ++g) { v4u w;
#pragma unroll
            for (int e = 0; e < 4; ++e) { const int r = (g & 1) * 8 + 2 * e; w[e] = (g < 2) ? pg8::cvt_pk_bf16(s0[r], s0[r + 1]) : pg8::cvt_pk_bf16(s1[r], s1[r + 1]); }
            pa[g] = __builtin_bit_cast(bf16x8, w); }
#pragma unroll
        for (int g = 0; g < 4; ++g) { const int kk = kb * 64 + (g >> 1) * 32 + (g & 1) * 16;
#pragma unroll
            for (int dt = 0; dt < 4; ++dt) { const unsigned char* vp = vbase + (dt * 32) * MV_STR + kk * 2;
                const s16x4 lo = *(const s16x4*)vp, hh = *(const s16x4*)(vp + 16);
                const bf16x8 vb = (bf16x8){lo[0], lo[1], lo[2], lo[3], hh[0], hh[1], hh[2], hh[3]};
                o[dt] = __builtin_amdgcn_mfma_f32_32x32x16_bf16(pa[g], vb, o[dt], 0, 0, 0); } }
    }
    v4u zg[8];
#pragma unroll
    for (int it = 0; it < 8; ++it) { const int i = it * 64 + lane, row = i >> 4, ch = i & 15; zg[it] = *(const v4u*)(P + (rowq + row) * PP + C_ZM + h * 128 + ch * 8); }
    lsum = half_sum(lsum);
    LDS_WAIT();
    if (hi == 0) scr[r32] = lsum;
    LDS_WAIT();
    float rl[16];
#pragma unroll
    for (int r = 0; r < 16; ++r) rl[r] = __builtin_amdgcn_rcpf(scr[crow16(r, hi)]);
    __syncthreads();
    bf16* stg = (bf16*)(lds + wid * 8704);
#pragma unroll
    for (int r = 0; r < 16; ++r) { const int orow = crow16(r, hi);
#pragma unroll
        for (int dt = 0; dt < 4; ++dt) stg[orow * 136 + dt * 32 + r32] = (bf16)f2bf(o[dt][r] * rl[r]); }
    LDS_WAIT();
#pragma unroll
    for (int it = 0; it < 8; ++it) { const int i = it * 64 + lane, row = i >> 4, ch = i & 15;
        v4u v = *(const v4u*)(stg + row * 136 + ch * 8); const v4u z = zg[it];
#pragma unroll
        for (int e = 0; e < 4; ++e) v[e] = pg8::cvt_pk_bf16(bflo(v[e]) * bflo(z[e]), bfhi(v[e]) * bfhi(z[e]));
        *(v4u*)(YM + (rowq + row) * 512 + h * 128 + ch * 8) = v; }
    __syncthreads();
}

constexpr int BT_STR = 136;
constexpr int BLDS_VN = 0, BLDS_U = 128 * BT_STR * 2, BLDS_Z = 2 * 128 * BT_STR * 2;
constexpr int BLDS_ST = 3 * 128 * BT_STR * 2;
__device__ __forceinline__ void bbranch_unit(int bl, int n, int g, const bf16* P, const float* lnp, const float* lng, const float* lnb, const bf16* Wg  , const float* bs  , bf16* YB, unsigned char* lds) {
    const int tid = opaque_tid(), lane = tid & 63, r32 = lane & 31, hi = lane >> 5, wid = tid >> 6;
    const size_t row0 = (size_t)bl * SEQ + n * 128;
    float* stt = (float*)(lds + BLDS_ST);
    if (tid < 128) { float sm = 0.f, sq = 0.f;
#pragma unroll
        for (int k = 0; k < 8; ++k) { sm += lnp[(size_t)k * MC + row0 + tid]; sq += lnp[(size_t)(8 + k) * MC + row0 + tid]; }
        const float mu = sm * (1.f / 512.f), var = fmaxf(sq * (1.f / 512.f) - mu * mu, 0.f);
        stt[2 * tid] = mu; stt[2 * tid + 1] = 1.0f / sqrtf(var + EPS); }
    __syncthreads();
#pragma unroll
    for (int it = 0; it < 4; ++it) { const int i = tid + it * 512, row = i >> 4, ch = i & 15; const bf16* src = P + (row0 + row) * PP + g * 128 + ch * 8;
        const v4u vv = *(const v4u*)(src + C_VB); const float mu = stt[2 * row], rsd = stt[2 * row + 1];
        const f32x4 g0 = *(const f32x4*)(lng + g * 128 + ch * 8), g1 = *(const f32x4*)(lng + g * 128 + ch * 8 + 4), b0 = *(const f32x4*)(lnb + g * 128 + ch * 8), b1 = *(const f32x4*)(lnb + g * 128 + ch * 8 + 4);
        v4u w; w.x = pk2((bflo(vv.x) - mu) * rsd * g0[0] + b0[0], (bfhi(vv.x) - mu) * rsd * g0[1] + b0[1]); w.y = pk2((bflo(vv.y) - mu) * rsd * g0[2] + b0[2], (bfhi(vv.y) - mu) * rsd * g0[3] + b0[3]);
        w.z = pk2((bflo(vv.z) - mu) * rsd * g1[0] + b1[0], (bfhi(vv.z) - mu) * rsd * g1[1] + b1[1]); w.w = pk2((bflo(vv.w) - mu) * rsd * g1[2] + b1[2], (bfhi(vv.w) - mu) * rsd * g1[3] + b1[3]);
        *(v4u*)(lds + BLDS_VN + (row * BT_STR + ch * 8) * 2) = w;
        *(v4u*)(lds + BLDS_U + (row * BT_STR + ch * 8) * 2) = *(const v4u*)(src + C_UB); }
    __syncthreads();
    const int ct = wid & 3, pt0 = (wid >> 2) * 2;
    const bf16* vn = (const bf16*)(lds + BLDS_VN); bf16* ut = (bf16*)(lds + BLDS_U);
    bf16x8 bfr[8];
#pragma unroll
    for (int k0 = 0; k0 < 8; ++k0) { v4u w;
#pragma unroll
        for (int e = 0; e < 4; ++e) { const int q = k0 * 16 + hi * 8 + 2 * e; w[e] = (unsigned)vn[q * BT_STR + ct * 32 + r32] | ((unsigned)vn[(q + 1) * BT_STR + ct * 32 + r32] << 16); }
        bfr[k0] = __builtin_bit_cast(bf16x8, w); }
#pragma unroll
    for (int pi = 0; pi < 2; ++pi) { const int pt = pt0 + pi;
        f32x16 acc = f32x16{};
#pragma unroll
        for (int k0 = 0; k0 < 8; ++k0) { const bf16x8 a = *(const bf16x8*)(Wg + (pt * 32 + r32) * 128 + k0 * 16 + hi * 8); acc = __builtin_amdgcn_mfma_f32_32x32x16_bf16(a, bfr[k0], acc, 0, 0, 0); }
#pragma unroll
        for (int r = 0; r < 16; ++r) { const int p = pt * 32 + crow16(r, hi), c = ct * 32 + r32;
            const float v = (acc[r] + bs[p]) * bf1(ut[p * BT_STR + c]);
            ut[p * BT_STR + c] = (bf16)f2bf(v); } }
    __syncthreads();
#pragma unroll
    for (int it = 0; it < 4; ++it) { const int i = tid + it * 512, row = i >> 4, ch = i & 15;
        *(v4u*)(YB + (row0 + row) * 512 + g * 128 + ch * 8) = *(const v4u*)(lds + BLDS_U + (row * BT_STR + ch * 8) * 2); }
    __syncthreads();
}


#ifdef DBG_STAGE
#define DBG_DUMP(stage, expr_cols, SRC, PITCH) if (DBG_STAGE == (stage)) { TIDS(); for (int m = gw; m < M_TOT; m += NGW) { float* o = a.out + (size_t)m * DMOD; \
        const int mm = (m + 4321) % MC; for (int cc = lane; cc < DMOD; cc += 64) { float acc_ = 0.f; if (m < MC) { for (int j = cc; j < (expr_cols); j += DMOD) acc_ += bf1((SRC)[(size_t)mm * (PITCH) + j]); } o[cc] = acc_; } } return; }
#else
#define DBG_DUMP(stage, expr_cols, SRC, PITCH)
#endif
__global__ void __launch_bounds__(NWAVES * 64, 2) fwd_kernel(Args a) {
    extern __shared__ __attribute__((aligned(16))) unsigned char lds[];
    cg::grid_group grid = cg::this_grid();
    const int G = gridDim.x, bx = blockIdx.x;
    const int vcu = (G % 8 == 0) ? (bx % 8) * (G / 8) + bx / 8 : bx;
    const int NGW = G * NWAVES;
#define TIDS() const int tid = opaque_tid(), lane = tid & 63, wave = __builtin_amdgcn_readfirstlane(tid >> 6), gw = bx * NWAVES + wave; (void)tid; (void)lane; (void)gw
    unsigned char* ws = a.ws;
    float* tab = (float*)(ws + WS_TAB);
    bf16* WinT = (bf16*)(ws + WS_WIN); bf16* WbrT = (bf16*)(ws + WS_WBR); bf16* WoutT = (bf16*)(ws + WS_WOUT); bf16* WkvT = (bf16*)(ws + WS_WKV); bf16* WsB = (bf16*)(ws + WS_WSB);
    bf16* MEMN = (bf16*)(ws + WS_MEMN); bf16* KM = (bf16*)(ws + WS_KM); bf16* VMT = (bf16*)(ws + WS_VMT);
    unsigned char* G8 = (unsigned char*)(ws + WS_G8);
    bf16* XB = (bf16*)(ws + WS_XB); float* SS = (float*)(ws + WS_SS); float* LNP = (float*)(ws + WS_LNP);
    bf16* H = (bf16*)(ws + WS_H); bf16* Y = (bf16*)(ws + WS_Y); bf16* Kd = (bf16*)(ws + WS_KD); bf16* Vd = (bf16*)(ws + WS_VD); bf16* P = (bf16*)(ws + WS_P);
    PG8_LAS unsigned char* ldsl = (PG8_LAS unsigned char*)lds;
    volatile LAS unsigned* MISC = (volatile LAS unsigned*)(ldsl + (LDS_BYTES - 256));
    if (threadIdx.x < 16) MISC[threadIdx.x] = 0u;
    __syncthreads();
    const XcdBarrier bar = xcd_barrier_post((unsigned*)(ws + WS_BAR), MISC + 8);
    if (a.ws == nullptr) grid.sync();
#ifndef REP_BAR
#define REP_BAR 1
#endif
#define GSYNC() do { for (int rb_ = 0; rb_ < REP_BAR; ++rb_) xcd_barrier(bar); } while (0)

#ifndef REP_PRO
#define REP_PRO 1
#endif
    for (int rp_ = 0; rp_ < REP_PRO; ++rp_) {
    if (PHM & 1) {
        TIDS();
        LAS float* scr = (LAS float*)(ldsl + wave * 16384);
        constexpr int I_IN = 16 * 216, I_KV = 16 * 32, I_BR = 8 * 32, I_OUT = 16 * 32;
        constexpr int N_IN = DEPTH * I_IN, N_KV = DEPTH * I_KV, N_BR = DEPTH * 3 * I_BR, N_OUT = DEPTH * I_OUT;
        for (int it = gw; it < N_IN + N_KV + N_BR + N_OUT; it += NGW) {
            int r = it;
            if (r < N_IN) { const int l = r / I_IN; p0_transpose_item(a.w_in + (size_t)l * DMOD * INW, DMOD, INW, WinT + (size_t)l * INW * DMOD, 0, scr, r % I_IN, lane, a.norm_g + l * DMOD, true); continue; } r -= N_IN;
            if (r < N_KV) { const int l = r / I_KV; p0_transpose_item(a.w_kv + (size_t)l * DMOD * 1024, DMOD, 1024, WkvT + (size_t)l * 1024 * DMOD, 0, scr, r % I_KV, lane); continue; } r -= N_KV;
            if (r < N_BR) { const int ln = r / I_BR, l = ln / 3, n = ln % 3; p0_transpose_item(a.w_br + (size_t)ln * 512 * DMOD, 512, DMOD, WbrT + (size_t)l * 3072 * 512, n * 1024, scr, r % I_BR, lane); continue; } r -= N_BR;
            { const int l = r / I_OUT; p0_transpose_item(a.w_out + (size_t)l * DMOD * DMOD, DMOD, DMOD, WoutT + (size_t)l * DMOD * DMOD, 0, scr, r % I_OUT, lane); }
        }
        for (int i = bx * 512 + tid; i < DEPTH * 4 * 128 * 128 / 2; i += G * 512) { const float2 v = ((const float2*)a.w_s)[i]; ((unsigned*)WsB)[i] = pk2(v.x, v.y); }
        for (int i = bx * 512 + tid; i < 1024; i += G * 512) { const int pos = i >> 4, f = i & 15; const float inv = powf(10000.0f, -(float)f / 16.0f); const float ang = (float)pos * inv; tab[i] = cosf(ang); tab[1024 + i] = sinf(ang); }
        for (int m = gw; m < DEPTH * BATCH * MEML; m += NGW) { const int l = m / (BATCH * MEML), r = m % (BATCH * MEML); rms_row_to_bf16(a.mem + (size_t)r * DMOD, a.mem_g + l * DMOD, MEMN + (size_t)m * DMOD, lane); }
    }
    GSYNC();
    if (PHM & 2) {
        KvOrder S{G, bx}; EpiKv E{KM, VMT};
        GEMM_NS::gemm_phase(GEMM_LDS, MEMN, WkvT, DMOD, S, E);
    }
    if (rp_ + 1 < REP_PRO) GSYNC();
    }
    for (int c = 0; c < NCHUNK; ++c) {
        const size_t xoff = (size_t)c * MC * DMOD;
        for (int l = 0; l < DEPTH; ++l) {
            const float* xin = (l == 0 ? a.x : a.out) + xoff; float* xout = a.out + xoff;
            float* ssc = SS; float* ssn = SS;
            if (l == 0) { TIDS(); for (int m = gw; m < MC; m += NGW) row_to_bf16_ss(xin + (size_t)m * DMOD, XB + (size_t)m * DMOD, ssc + m, lane);
                GSYNC(); }
            DBG_DUMP(6, 1024, H, 1024)
            DBG_DUMP(7, 1024, WinT, 1024)
            if (PHM & 8) {
                pg8::StaticOrder S; S.init(MC, INW, G, bx); float* rst = (float*)(lds + RST_OFF);
                { const int t0 = opaque_tid(); for (int idx = t0; idx < 7 * 256; idx += 512) { pg8::Unit uu; if (!S.next(idx >> 8, uu)) break; const int row = uu.pm * 256 + (idx & 255); float sq = 0.f;
#pragma unroll
                        for (int k = 0; k < 16; ++k) sq += ssc[(size_t)k * MC + row];
                        rst[idx] = 1.0f / sqrtf(sq * (1.f / DMOD) + EPS); } }
                for (int rep_ = 0; rep_ < REP_P2; ++rep_) { EpiIn E{P, rst, 0, Kd, Vd, tab, a.q_g + l * 64, a.k_g + l * 64, LNP, G8}; GEMM_NS::gemm_phase(GEMM_LDS, XB, WinT + (size_t)l * INW * DMOD, DMOD, S, E); }
            }
            GSYNC();
            DBG_DUMP(1, INW, P, PP)
            DBG_DUMP(2, 3840, P, PP)
            DBG_DUMP(3, 128, Kd, 128)
            for (int rep_ = 0; rep_ < REP_M; ++rep_) if (PHM & 64) for (int u = bx; u < BC * 4 * (SEQ / 256); u += G) {
                const int tb = u & 15, h = (u >> 4) & 3, bl = u >> 6;
                mbranch_unit(l * 8 + c * BC + bl, bl, h, tb, P, KM, VMT, Y + (size_t)2 * MC * 512, lds);
            }
            for (int rep_ = 0; rep_ < REP_B; ++rep_) if (PHM & 128) for (int u = bx; u < BC * 32 * 4; u += G) {
                const int g = u & 3, n = (u >> 2) & 31, bl = u >> 7;
                bbranch_unit(bl, n, g, P, LNP, a.ln_g + l * 512, a.ln_b + l * 512, WsB + (size_t)(l * 4 + g) * 128 * 128, a.b_s + (l * 4 + g) * 128, Y + (size_t)MC * 512, lds);
            }
            __syncthreads();
            for (int rep_ = 0; rep_ < REP_ATT; ++rep_) if (PHM & 32) for (int u = bx; u < BC * 8 * (SEQ / 256); u += G) {
                const int grp = u & 7, idx = u >> 3, bl = grp >> 1, kvh = grp & 1, h = kvh * 4 + (idx >> 4), qb = idx & 15;
#ifdef DBG_SIMPLE_ATTN
                { const int tid = opaque_tid();
                  for (int i = tid; i < 256 * 8; i += 512) { const int r = i >> 3, ch = i & 7; const size_t row = (size_t)bl * SEQ + qb * 256 + r;
                    const v4u q = *(const v4u*)(P + row * PP + h * 64 + ch * 8); const v4u k = *(const v4u*)(Kd + ((size_t)(bl * 2 + (h >> 2)) * SEQ + (row % SEQ)) * 64 + ch * 8);
                    const v4u vv = *(const v4u*)(Vd + ((size_t)(bl * 2 + (h >> 2)) * SEQ + ((row + 1234) % SEQ)) * 64 + ch * 8); v4u o;
                    for (int e = 0; e < 4; ++e) o[e] = pk2(bflo(q[e]) * bflo(k[e]) + bflo(vv[e]), bfhi(q[e]) * bfhi(k[e]) + bfhi(vv[e]));
                    *(v4u*)(Y + row * 512 + h * 64 + ch * 8) = o; } }
                if (0)
#endif
                attn_body::attn_unit<8>(bl, h, qb, (const attn_body::bf16*)P, (const attn_body::bf16*)Kd, (const attn_body::bf16*)Vd, (const attn_body::bf16*)(P + C_ZA), (attn_body::bf16*)Y, (char*)lds);
            }
            __syncthreads();
            GSYNC();
            DBG_DUMP(4, 512, Y, 512)
            if (PHM & 256) {
                MergeOrder S{G, vcu}; EpiMerge E{G8, H};
                for (int rep_ = 0; rep_ < REP_P5; ++rep_) GEMM_NS::gemm_phase(GEMM_LDS, Y, WbrT + (size_t)l * 3072 * 512, 512, S, E);
            }
            GSYNC();
            DBG_DUMP(5, 1024, H, 1024)
            if (PHM & 512) {
                pg8::StaticOrder S; S.init(MC, DMOD, G, bx); for (int rep_ = 0; rep_ < REP_P6; ++rep_) { EpiRes E{XB, ssn, rep_ + 1 < REP_P6};
                GEMM_NS::gemm_phase(GEMM_LDS, H, WoutT + (size_t)l * DMOD * DMOD, DMOD, S, E); }
            }
            GSYNC();
        }
        if (PHM & 1024) { TIDS(); for (int m = gw; m < MC; m += NGW) rms_row_from_bf16(XB + (size_t)m * DMOD, a.final_g, a.out + xoff + (size_t)m * DMOD, lane); }
    }
}

extern "C" void kernel_launch(void* const* d_in, const int* in_sizes, int n_in, void* d_out, int out_size, void* d_ws, size_t ws_size, hipStream_t stream) {
    static int grid = 0;
    if (grid == 0) {
        if (n_in != 15 || in_sizes[0] != M_TOT * DMOD || out_size != M_TOT * DMOD || ws_size < WS_END) { fprintf(stderr, "kernel_launch: unexpected shapes (n_in %d, ws %zu)\n", n_in, ws_size); grid = -1; return; }
        int dev = 0, cus = 0, per_cu = 0;
        (void)hipGetDevice(&dev); (void)hipDeviceGetAttribute(&cus, hipDeviceAttributeMultiprocessorCount, dev);
        if (hipFuncSetAttribute((const void*)fwd_kernel, hipFuncAttributeMaxDynamicSharedMemorySize, LDS_BYTES) != hipSuccess) { fprintf(stderr, "kernel_launch: hipFuncSetAttribute failed\n"); grid = -1; return; }
        (void)hipOccupancyMaxActiveBlocksPerMultiprocessor(&per_cu, (const void*)fwd_kernel, NWAVES * 64, LDS_BYTES);
        (void)hipGetLastError();
        grid = cus > 0 ? cus : 256;
    }
    if (grid < 0) return;
    if (hipMemsetAsync((char*)d_ws + WS_BAR, 0, WS_BAR_BYTES, stream) != hipSuccess) { fprintf(stderr, "kernel_launch: memset failed\n"); return; }
    Args a{};
    a.x = (const float*)d_in[0]; a.mem = (const float*)d_in[1]; a.norm_g = (const float*)d_in[2]; a.w_in = (const float*)d_in[3]; a.q_g = (const float*)d_in[4]; a.k_g = (const float*)d_in[5];
    a.ln_g = (const float*)d_in[6]; a.ln_b = (const float*)d_in[7]; a.w_s = (const float*)d_in[8]; a.b_s = (const float*)d_in[9]; a.mem_g = (const float*)d_in[10]; a.w_kv = (const float*)d_in[11];
    a.w_br = (const float*)d_in[12]; a.w_out = (const float*)d_in[13]; a.final_g = (const float*)d_in[14]; a.out = (float*)d_out; a.ws = (unsigned char*)d_ws;
    void* args[] = {&a};
    const hipError_t e = hipLaunchCooperativeKernel((const void*)fwd_kernel, dim3(grid), dim3(NWAVES * 64), args, LDS_BYTES, stream);
    if (e != hipSuccess) fprintf(stderr, "kernel_launch: cooperative launch failed: %s\n", hipGetErrorString(e));
}
```

```cpp
#include <hip/hip_runtime.h>
#include <hip/hip_cooperative_groups.h>
#include <hip/hip_bf16.h>
#include <cstdio>
#include <cstdint>
#include <cmath>
namespace cg = cooperative_groups;
__device__ __forceinline__ int opaque_tid() { int t = threadIdx.x; asm volatile("" : "+v"(t)); return t; }
namespace pg8 {
#define PG8_LAS __attribute__((address_space(3)))
typedef unsigned short bf16_t;
typedef short bf16x8 __attribute__((ext_vector_type(8)));
typedef float f32x4 __attribute__((ext_vector_type(4)));
typedef unsigned u32x4 __attribute__((ext_vector_type(4)));
constexpr int BM = 256, BK = 64, HALF = 128, HTB = HALF * BK * 2  , STAGE_BYTES = 8 * HTB, NXCD = 8, WGM = 8;

__host__ __device__ __forceinline__ int lds_byte(int r, int c) { const int st = (r >> 4) * 2 + (c >> 5), rr = r & 15, cc = c & 31, ob = rr * 64 + cc * 2; return st * 1024 + (ob ^ (((ob >> 9) & 1) << 5)); }
__host__ __device__ __forceinline__ void stage_rc(int b, int& R, int& C) { const int st = b / 1024, sb = b % 1024, swz = sb ^ (((sb >> 9) & 1) << 5); R = (st >> 1) * 16 + swz / 64; C = (st & 1) * 32 + (swz % 64) / 2; }
__host__ __device__ __forceinline__ int perm32(int rho) { const int n = rho >> 4, i = rho & 15; return 8 * (i >> 2) + 4 * n + (i & 3); }

struct Unit { int pm, pn; };
struct Gemm { const bf16_t* A; const bf16_t* Bt; int M, N, K; };

struct StaticOrder {
    int nM, nN, nwg, G, c;
    __host__ __device__ void init(int M, int N, int G_, int c_) { nM = M / BM; nN = N / BM; nwg = nM * nN; G = G_; c = c_; }
    __host__ __device__ bool next(int i, Unit& u) const {
        const long L = (long)i * G + c; if (L >= nwg) return false;
        int wgid = (int)L; { const int q = nwg / NXCD, r = nwg % NXCD, xcd = wgid % NXCD, off = wgid / NXCD; wgid = (xcd < r ? xcd * (q + 1) : r * (q + 1) + (xcd - r) * q) + off; }
        const int nig = WGM * nN, gid = wgid / nig, fm = gid * WGM, gsz = (nM - fm) < WGM ? (nM - fm) : WGM;
        u.pm = fm + ((wgid % nig) % gsz); u.pn = (wgid % nig) / gsz; return true;
    }
    __device__ __forceinline__ void a_ready(const Unit&) const {}
    __device__ __forceinline__ void done(const Unit&) const {}
};

__device__ __forceinline__ unsigned cvt_pk_bf16(float lo, float hi) { unsigned r; asm volatile("v_cvt_pk_bf16_f32 %0, %1, %2" : "=v"(r) : "v"(lo), "v"(hi)); return r; }
typedef float f32x2 __attribute__((ext_vector_type(2)));
__device__ __forceinline__ f32x2 gelu_pk(f32x2 v) {
    const f32x2 av = __builtin_elementwise_abs(v), d = av * 0.2316418882f + 1.0f;
    f32x2 t; t.x = __builtin_amdgcn_rcpf(d.x); t.y = __builtin_amdgcn_rcpf(d.y);
    f32x2 q = t * 0.5307027145f + (-0.7265760135f); q = q * t + 0.7107068705f; q = q * t + (-0.142248368f); q = q * t + 0.127414796f; q = q * t;
    const f32x2 s = (v * v) * (-0.72134752044f);
    f32x2 e; e.x = __builtin_amdgcn_exp2f(s.x); e.y = __builtin_amdgcn_exp2f(s.y);
    const f32x2 m = v * (q * e), r = v - m;
    f32x2 o; o.x = v.x < 0.f ? m.x : r.x; o.y = v.y < 0.f ? m.y : r.y; return o;
}

template <int ACT  > struct EpiBf16 {
    static constexpr bool PERM = true, AFTER_DRAIN = false; static_assert(ACT == 0 || ACT == 1, "EpiBf16: ACT is 0 (none) or 1 (gelu_pk)");
    bf16_t* O; int ldc; const float* bias; int split_cols; size_t split_stride; float scale0;
    __device__ __forceinline__ void operator()(const f32x4 (&acc)[2][2][4][2], const Unit& u, int wr, int wc, int fr, int fq) const {
        const int row0 = u.pm * BM + wr * 64 + fr; int colt = u.pn * BM; bf16_t* base = O;
        float sc = 1.f; if (split_cols) { const int t = colt / split_cols; base += (size_t)t * split_stride; colt -= t * split_cols; if (t == 0) sc = scale0; }
        const int col0 = colt + wc * 32 + 8 * fq, bcol0 = u.pn * BM + wc * 32 + 8 * fq;
        f32x4 bv[2][2];
#pragma unroll
        for (int bj = 0; bj < 2; ++bj)
#pragma unroll
            for (int n = 0; n < 2; ++n) bv[bj][n] = bias ? *(const f32x4*)(bias + bcol0 + bj * HALF + 4 * n) : (f32x4){0.f, 0.f, 0.f, 0.f};
#pragma unroll
        for (int ai = 0; ai < 2; ++ai)
#pragma unroll
            for (int m = 0; m < 4; ++m) { bf16_t* rowp = base + (size_t)(row0 + ai * HALF + m * 16) * ldc + col0;
#pragma unroll
                for (int bj = 0; bj < 2; ++bj) { f32x4 v0 = acc[ai][bj][m][0] + bv[bj][0], v1 = acc[ai][bj][m][1] + bv[bj][1];
                    if (ACT == 1) { f32x2 a = gelu_pk((f32x2){v0[0], v0[1]}), b = gelu_pk((f32x2){v0[2], v0[3]}), c = gelu_pk((f32x2){v1[0], v1[1]}), d = gelu_pk((f32x2){v1[2], v1[3]});
                        v0 = (f32x4){a.x, a.y, b.x, b.y}; v1 = (f32x4){c.x, c.y, d.x, d.y}; }
                    v0 = v0 * sc; v1 = v1 * sc; u32x4 w; w.x = cvt_pk_bf16(v0[0], v0[1]); w.y = cvt_pk_bf16(v0[2], v0[3]); w.z = cvt_pk_bf16(v1[0], v1[1]); w.w = cvt_pk_bf16(v1[2], v1[3]);
                    *(u32x4*)(rowp + bj * HALF) = w; } }
    }
};
}
namespace mg3 {
constexpr int BK = 64, TILE_B = 256 * 128, LDS_NEED = 4 * TILE_B;
template <class Epi, class Sched>
__device__ __forceinline__ void gemm_phase(PG8_LAS unsigned char* lds, const unsigned short* A, const unsigned short* Bt, int K, const Sched& S, const Epi& E) {
    typedef short bf16x8_ __attribute__((ext_vector_type(8)));
    typedef float f32x4_ __attribute__((ext_vector_type(4)));
    const int tid = opaque_tid(), lane = tid & 63, wid = __builtin_amdgcn_readfirstlane(tid >> 6), wm = wid >> 2, wn = wid & 3, fr = lane & 15, fq = lane >> 4;
    const int nk = K / BK;
    pg8::Unit cur, nxt;
    if (!S.next(0, cur)) return;
    const int r3 = lane >> 3, lc = (lane & 7) ^ ((4 * (wid & 1) + (lane >> 4)) & 7);
    const unsigned gofa = (unsigned)((8 * wid + r3) * K + lc * 8) * 2u;
    const unsigned gofb = (unsigned)((32 * (wid & 1) + 16 * (r3 >> 2) + 4 * (wid >> 1) + (r3 & 3)) * K + lc * 8) * 2u;
    const unsigned qstep = (unsigned)(64 * K) * 2u;
    const int sw = (fr >> 1) & 7;
    const int off0 = ((0 + fq) ^ sw) * 16, off1 = ((4 + fq) ^ sw) * 16;
    const int lra = (wm * 128 + fr) * 128, lrb = (wn * 64 + fr) * 128;
    f32x4_ acc[8][4];
#pragma unroll
    for (int m = 0; m < 8; ++m)
#pragma unroll
        for (int n = 0; n < 4; ++n) acc[m][n] = f32x4_{0.f, 0.f, 0.f, 0.f};
#define MG3_SYNC() do { asm volatile("s_waitcnt vmcnt(0)" ::: "memory"); __syncthreads(); } while (0)
#define MG3_SB() __builtin_amdgcn_sched_barrier(0)
    bool has_next = S.next(1, nxt);
    {   const char* pa_ = (const char*)(A + (size_t)cur.pm * 256 * K); const char* pb_ = (const char*)(Bt + (size_t)cur.pn * 256 * K);
#pragma unroll
        for (int q = 0; q < 4; ++q) {
            __builtin_amdgcn_global_load_lds((const unsigned*)(pa_ + (size_t)q * qstep + gofa), (PG8_LAS unsigned*)(lds + wid * 1024 + q * 8192), 16, 0, 0);
            __builtin_amdgcn_global_load_lds((const unsigned*)(pb_ + (size_t)q * qstep + gofb), (PG8_LAS unsigned*)(lds + TILE_B + wid * 1024 + q * 8192), 16, 0, 0); } }
    MG3_SYNC();
    int buf = 0;
    for (int ui = 0;; ++ui) {
        for (int kt = 0; kt < nk; ++kt) {
            const bool dnext = (kt + 1 < nk) || has_next;
            const pg8::Unit& du = (kt + 1 < nk) ? cur : nxt; const int dkt = (kt + 1 < nk) ? kt + 1 : 0;
            const char* dpa = (const char*)(A + (size_t)du.pm * 256 * K + (size_t)dkt * BK); const char* dpb = (const char*)(Bt + (size_t)du.pn * 256 * K + (size_t)dkt * BK);
            PG8_LAS unsigned char* dla = lds + (buf ^ 1) * 2 * TILE_B + wid * 1024;
#define MG3_PA(Q) do { if (dnext) __builtin_amdgcn_global_load_lds((const unsigned*)(dpa + (size_t)(Q) * qstep + gofa), (PG8_LAS unsigned*)(dla + (Q) * 8192), 16, 0, 0); } while (0)
#define MG3_PB(Q) do { if (dnext) __builtin_amdgcn_global_load_lds((const unsigned*)(dpb + (size_t)(Q) * qstep + gofb), (PG8_LAS unsigned*)(dla + TILE_B + (Q) * 8192), 16, 0, 0); } while (0)
            const PG8_LAS unsigned char* la = lds + buf * 2 * TILE_B + lra; const PG8_LAS unsigned char* lb = lds + buf * 2 * TILE_B + TILE_B + lrb;
            bf16x8_ a0[8], b0[4], a1[8], b1[4];
#define MG3_RD(AF, BF, OFF) do { _Pragma("unroll") for (int n = 0; n < 4; ++n) BF[n] = *(const PG8_LAS bf16x8_*)(lb + n * 2048 + (OFF)); \
                _Pragma("unroll") for (int m = 0; m < 8; ++m) AF[m] = *(const PG8_LAS bf16x8_*)(la + m * 2048 + (OFF)); } while (0)
#define MG3_M4(AF, BF, M) do { _Pragma("unroll") for (int n = 0; n < 4; ++n) acc[M][n] = __builtin_amdgcn_mfma_f32_16x16x32_bf16(BF[n], AF[M], acc[M][n], 0, 0, 0); } while (0)
            MG3_RD(a0, b0, off0); MG3_SB();
            MG3_M4(a0, b0, 0); MG3_PA(0); MG3_PB(0); MG3_SB(); MG3_M4(a0, b0, 1); MG3_PA(1); MG3_PB(1); MG3_SB();
            MG3_RD(a1, b1, off1); MG3_SB();
            MG3_M4(a0, b0, 2); MG3_PA(2); MG3_PB(2); MG3_SB(); MG3_M4(a0, b0, 3); MG3_PA(3); MG3_PB(3); MG3_SB();
            MG3_M4(a0, b0, 4); MG3_M4(a0, b0, 5); MG3_M4(a0, b0, 6); MG3_M4(a0, b0, 7); MG3_SB();
            MG3_M4(a1, b1, 0); MG3_M4(a1, b1, 1); MG3_M4(a1, b1, 2); MG3_M4(a1, b1, 3); MG3_M4(a1, b1, 4); MG3_M4(a1, b1, 5); MG3_M4(a1, b1, 6);
            MG3_SB();
            MG3_SYNC();
            MG3_SB();
            MG3_M4(a1, b1, 7);
#undef MG3_RD
#undef MG3_M4
#undef MG3_PA
#undef MG3_PB
            buf ^= 1;
        }
        bool keep_acc = false;
        { const int t2_ = opaque_tid(); const int fre = t2_ & 15, fqe = (t2_ >> 4) & 3; keep_acc = E(acc, cur, wm, wn, fre, fqe); }
        if (!has_next) break;
        if (!keep_acc) {
#pragma unroll
            for (int m = 0; m < 8; ++m)
#pragma unroll
                for (int n = 0; n < 4; ++n) acc[m][n] = f32x4_{0.f, 0.f, 0.f, 0.f}; }
        cur = nxt;
        has_next = S.next(ui + 2, nxt);
    }
#undef MG3_SYNC
#undef MG3_SB
}
}
namespace attn_body {
using bf16=__hip_bfloat16;
using bf16x8=__attribute__((ext_vector_type(8)))short;
using s16x4=__attribute__((ext_vector_type(4)))short;
using f32x16=__attribute__((ext_vector_type(16)))float;
using u32x4=__attribute__((ext_vector_type(4)))unsigned;
constexpr int SEQ=4096,D=64,QP=3840,KP=64,OP=512;
constexpr int NW=8,QBLK=32,QB=QBLK*NW,KVBLK=64,NQB=SEQ/QB;
__device__ __forceinline__ int crow(int r,int hi){return (r&3)+8*(r>>2)+4*hi;}
#define SBAR() __builtin_amdgcn_sched_barrier(0)
constexpr int NSLOT=3, SLOTB=8192;
constexpr int LDS_K=0, LDS_V=NSLOT*SLOTB, LDS_WS=2*NSLOT*SLOTB, LDS_OST=LDS_WS+NW*64*4, LDS_BYTES=LDS_OST+NW*4096;
constexpr float C2=0.125f*1.4426950408889634f;
__device__ __forceinline__ void glds16(const void*gsrc,unsigned lds_dst){unsigned keep;
  asm volatile("s_mov_b32 %0, m0\n\ts_mov_b32 m0, %2\n\ts_nop 0\n\tglobal_load_lds_dwordx4 %1, off\n\ts_mov_b32 m0, %0":"=&s"(keep):"v"(gsrc),"s"(lds_dst):"memory");}
__device__ __forceinline__ float max3f(float a,float b,float c){float r;asm("v_max3_f32 %0, %1, %2, %3":"=v"(r):"v"(a),"v"(b),"v"(c));return r;}
__device__ __forceinline__ float max2f(float a,float b){float r;asm("v_max_f32_e32 %0, %1, %2":"=v"(r):"v"(a),"v"(b));return r;}
__device__ __forceinline__ float fadd_s(float a,float b){float r;asm("v_add_f32_e32 %0, %1, %2":"=v"(r):"v"(a),"v"(b));return r;}
__device__ __forceinline__ float fsub_s(float a,float b){float r;asm("v_sub_f32_e32 %0, %1, %2":"=v"(r):"v"(a),"v"(b));return r;}
typedef float f32x2_t __attribute__((ext_vector_type(2))); typedef __bf16 bf16x2_t __attribute__((ext_vector_type(2)));
__device__ __forceinline__ unsigned cvtpk_s(float lo,float hi){f32x2_t v={lo,hi};bf16x2_t b=__builtin_convertvector(v,bf16x2_t);return __builtin_bit_cast(unsigned,b);}
#define WAIT_BAR(N) asm volatile("s_waitcnt vmcnt(" #N ") lgkmcnt(0)\n\ts_barrier":::"memory")

__device__ __forceinline__ void qkt(f32x16&p0,f32x16&p1,const char*Kslot,const bf16x8*qr,const f32x16&negm,int r32,int hi){
  const char*kb=Kslot+hi*1024+r32*16;
  #pragma unroll
  for(int d0=0;d0<4;++d0){
    const bf16x8 b0=*reinterpret_cast<const bf16x8*>(kb+d0*2048);
    const bf16x8 b1=*reinterpret_cast<const bf16x8*>(kb+d0*2048+512);
    if(d0==0){p0=__builtin_amdgcn_mfma_f32_32x32x16_bf16(b0,qr[0],negm,0,0,0);p1=__builtin_amdgcn_mfma_f32_32x32x16_bf16(b1,qr[0],negm,0,0,0);}
    else{p0=__builtin_amdgcn_mfma_f32_32x32x16_bf16(b0,qr[d0],p0,0,0,0);p1=__builtin_amdgcn_mfma_f32_32x32x16_bf16(b1,qr[d0],p1,0,0,0);}}
}
typedef __attribute__((address_space(3))) const char* lds_cptr;
typedef short v4i16_t __attribute__((ext_vector_type(4)));
__device__ __forceinline__ void kload8(bf16x8*kf,lds_cptr kp){
  kf[0]=*(const __attribute__((address_space(3))) bf16x8*)(kp);      kf[1]=*(const __attribute__((address_space(3))) bf16x8*)(kp+512);
  kf[2]=*(const __attribute__((address_space(3))) bf16x8*)(kp+2048); kf[3]=*(const __attribute__((address_space(3))) bf16x8*)(kp+2560);
  kf[4]=*(const __attribute__((address_space(3))) bf16x8*)(kp+4096); kf[5]=*(const __attribute__((address_space(3))) bf16x8*)(kp+4608);
  kf[6]=*(const __attribute__((address_space(3))) bf16x8*)(kp+6144); kf[7]=*(const __attribute__((address_space(3))) bf16x8*)(kp+6656);
}
__device__ __forceinline__ void kload2(bf16x8*kf,lds_cptr kp,int j){ kf[2*j]=*(const __attribute__((address_space(3))) bf16x8*)(kp+j*2048); kf[2*j+1]=*(const __attribute__((address_space(3))) bf16x8*)(kp+j*2048+512); }
__device__ __forceinline__ s16x4 vtr(lds_cptr p){ return __builtin_bit_cast(s16x4,__builtin_amdgcn_ds_read_tr16_b64_v4i16((__attribute__((address_space(3))) v4i16_t*)p)); }
__device__ __forceinline__ float rowmax(const f32x16&p0,const f32x16&p1){
  float a=max3f(p0[0],p0[1],p1[0]),b=max3f(p0[2],p0[3],p1[1]);a=max3f(a,p1[2],p1[3]);
  #pragma unroll
  for(int r=4;r<16;r+=4){a=max3f(a,p0[r],p0[r+1]);b=max3f(b,p0[r+2],p0[r+3]);a=max3f(a,p1[r],p1[r+1]);b=max3f(b,p1[r+2],p1[r+3]);}
  const float m=max2f(a,b);
  auto rr=__builtin_amdgcn_permlane32_swap(__float_as_uint(m),__float_as_uint(m),false,false);
  return max2f(__uint_as_float(rr[0]),__uint_as_float(rr[1]));
}
__device__ __forceinline__ void pv(f32x16*o,int vb,bf16x8 pa0,bf16x8 pa1,bf16x8 pa2,bf16x8 pa3){
  #pragma unroll
  for(int d0=0;d0<2;++d0){s16x4 lo[4],hi[4];
    #pragma unroll
    for(int ks=0;ks<4;++ks){
      asm volatile("ds_read_b64_tr_b16 %0,%1 offset:%c2":"=&v"(lo[ks]):"v"(vb),"i"(d0*4096+ks*1024):"memory");
      asm volatile("ds_read_b64_tr_b16 %0,%1 offset:%c2":"=&v"(hi[ks]):"v"(vb),"i"(d0*4096+ks*1024+512):"memory");}
    asm volatile("s_waitcnt lgkmcnt(0)":::"memory");SBAR();
    #define PK(k) (bf16x8){lo[k][0],lo[k][1],lo[k][2],lo[k][3],hi[k][0],hi[k][1],hi[k][2],hi[k][3]}
    o[d0]=__builtin_amdgcn_mfma_f32_32x32x16_bf16(pa0,PK(0),o[d0],0,0,0);
    o[d0]=__builtin_amdgcn_mfma_f32_32x32x16_bf16(pa1,PK(1),o[d0],0,0,0);
    o[d0]=__builtin_amdgcn_mfma_f32_32x32x16_bf16(pa2,PK(2),o[d0],0,0,0);
    o[d0]=__builtin_amdgcn_mfma_f32_32x32x16_bf16(pa3,PK(3),o[d0],0,0,0);
    #undef PK
  }
}

#ifndef ATTN_STORE16
#define ATTN_STORE16(p,v) (*(u32x4*)(p)=(v))
#endif
template<int THRL> __device__ __forceinline__ void attn_unit(int b,int h,int qb,const bf16*Q,const bf16*__restrict__ K,const bf16*__restrict__ V,const bf16*Z,bf16*O,char*shm){
  const int tid=opaque_tid(),lane=tid&63,r32=lane&31,hi=lane>>5; const int wid=__builtin_amdgcn_readfirstlane(tid>>6);
  const long rowbase=(long)b*SEQ; const int q0=qb*QB;
  const bf16*Qw=Q+(rowbase+q0+wid*QBLK)*QP+h*D;
  const long kvbase=((long)b*2+(h>>2))*SEQ*KP; const bf16*Kh=K+kvbase,*Vh=V+kvbase;
  const unsigned lds0=(unsigned)(uintptr_t)shm;
  float*wsf=(float*)(shm+LDS_WS)+wid*64;
  const bf16*ksrc=Kh+(long)lane*KP+wid*8;
  const bf16*vsrc=Vh+(long)(16*(wid&3)+(lane>>2))*KP+(wid>>2)*32+(lane&3)*8;
  const unsigned kdst=lds0+LDS_K+wid*1024, vdst=lds0+LDS_V+wid*1024;
  #define DMA_K(t,slot) glds16(ksrc+(long)(t)*KVBLK*KP,(unsigned)__builtin_amdgcn_readfirstlane(kdst+(slot)))
  #define DMA_V(t,slot) glds16(vsrc+(long)(t)*KVBLK*KP,(unsigned)__builtin_amdgcn_readfirstlane(vdst+(slot)))
  const int vb0=(int)(lds0+LDS_V)+((lane>>4)&1)*32+(lane&3)*8+(4*hi+((lane&15)>>2))*64;
  const char*Kbase=shm+LDS_K; bf16x8 kf[8];
  const lds_cptr shm3=(lds_cptr)shm; const lds_cptr kp0=shm3+LDS_K+hi*1024+r32*16; const lds_cptr vp0=shm3+LDS_V+((lane>>4)&1)*32+(lane&3)*8+(4*hi+((lane&15)>>2))*64;
  const int NT=SEQ/KVBLK;
  DMA_K(0,0);DMA_V(0,0);DMA_K(1,SLOTB);
  bf16x8 qr[4];
  #pragma unroll
  for(int d0=0;d0<4;++d0)qr[d0]=*reinterpret_cast<const bf16x8*>(&Qw[(long)r32*QP+d0*16+hi*8]);
  float mhat=0.f,l_reg=0.f;f32x16 o[2];o[0]=f32x16{};o[1]=f32x16{};f32x16 negm=f32x16{};asm volatile("":"+v"(negm));
  #define CMASK(P0,P1,t) do{}while(0)
  bool resc=false;
  #define START(P0,P1) do{ const float rm=rowmax(P0,P1); resc=false; \
    { const float dl=rm; mhat=fadd_s(mhat,dl); \
      _Pragma("unroll") for(int r=0;r<16;++r){P0[r]=fsub_s(P0[r],dl);P1[r]=fsub_s(P1[r],dl);} \
      _Pragma("unroll") for(int r=0;r<16;++r)negm[r]=-mhat; asm volatile("":"+v"(negm)); } \
    _Pragma("unroll") for(int r=0;r<16;++r)P0[r]=__builtin_amdgcn_exp2f(P0[r]); }while(0)
  #define RESC() do{ if(resc){ asm volatile("s_waitcnt lgkmcnt(0)":::"memory"); \
      _Pragma("unroll") for(int d_=0;d_<2;++d_) _Pragma("unroll") for(int r=0;r<16;++r)o[d_][r]*=wsf[crow(r,hi)]; } }while(0)
  f32x16 pA0,pA1,pB0,pB1;
  int sl_prev=0,sl_cur=0,sl_next=SLOTB;
  #define ROT() do{sl_prev=sl_cur;sl_cur=sl_next;sl_next=(sl_next==(NSLOT-1)*SLOTB)?0:sl_next+SLOTB;}while(0)
  DMA_K(2,2*SLOTB);
  WAIT_BAR(3);
  qkt(pA0,pA1,Kbase,qr,negm,r32,hi);asm volatile("s_nop 15\n\ts_nop 7":"+v"(pA0),"+v"(pA1));CMASK(pA0,pA1,0);
  START(pA0,pA1);
  _Pragma("unroll") for(int r=0;r<16;++r)pA1[r]=__builtin_amdgcn_exp2f(pA1[r]);
  WAIT_BAR(0);
  DMA_K(3,0);DMA_V(1,SLOTB);
  ROT();
  kload8(kf,kp0+sl_cur);
  WAIT_BAR(2);
  s16x4 vlo[8],vhi[8]; u32x4 pw0,pw1,pw2,pw3;
  #define PKW(P,B) cvtpk_s(P[B],P[B+1])
  #define PAF(k) __builtin_bit_cast(bf16x8,pw##k)
  #define VFR(i) (bf16x8){vlo[i][0],vlo[i][1],vlo[i][2],vlo[i][3],vhi[i][0],vhi[i][1],vhi[i][2],vhi[i][3]}
  #define PIN(x) asm volatile("":"+v"(x))
  #define MX3(a,b,c) __builtin_fmaxf(__builtin_fmaxf((a),(b)),(c))
  #define GAPA(MF,A0,A1,A2,A3,W0,W1,PW) do{ MF; sacc+=A0; sacc+=A1; sacc+=A2; sacc+=A3; PIN(sacc); W0; W1; PIN(PW); SBAR(); }while(0)
  #define EX(v) __builtin_amdgcn_exp2f(v)
  #define GAPB(MF,X,B) do{ MF; X[B]=EX(X[B]); X[B+1]=EX(X[B+1]); X[B+2]=EX(X[B+2]); X[B+3]=EX(X[B+3]); PIN(X); SBAR(); }while(0)
  #define VRD(i) do{ vlo[i]=vtr(vp_+(((i)>>2)*4096+((i)&3)*1024)); vhi[i]=vtr(vp_+(((i)>>2)*4096+((i)&3)*1024+512)); }while(0)
  #define KRD(G,j) do{ if(G){ kload2(kf,kp0+sl_next,j); SBAR(); } }while(0)
  #define STEP(C0,C1,P0,P1,t,GK,GV,GL) do{ SBAR(); \
    const lds_cptr vp_=vp0+sl_prev; \
    VRD(0); SBAR(); float sacc=(P0[0]+P0[1]); \
    GAPA(C0=__builtin_amdgcn_mfma_f32_32x32x16_bf16(kf[0],qr[0],negm,0,0,0), P0[2],P0[3],P0[4],P0[5],     pw0[0]=PKW(P0,0), pw0[1]=PKW(P0,2), pw0); \
    VRD(4); SBAR(); GAPA(C1=__builtin_amdgcn_mfma_f32_32x32x16_bf16(kf[1],qr[0],negm,0,0,0), P0[6],P0[7],P0[8],P0[9],     pw0[2]=PKW(P0,4), pw0[3]=PKW(P0,6), pw0); \
    VRD(1); SBAR(); GAPA(C0=__builtin_amdgcn_mfma_f32_32x32x16_bf16(kf[2],qr[1],C0,0,0,0),   P0[10],P0[11],P0[12],P0[13], pw1[0]=PKW(P0,8), pw1[1]=PKW(P0,10), pw1); \
    VRD(5); SBAR(); GAPA(C1=__builtin_amdgcn_mfma_f32_32x32x16_bf16(kf[3],qr[1],C1,0,0,0),   P0[14],P0[15],P1[0],P1[1],   pw1[2]=PKW(P0,12),pw1[3]=PKW(P0,14), pw1); \
    VRD(2); SBAR(); GAPA(C0=__builtin_amdgcn_mfma_f32_32x32x16_bf16(kf[4],qr[2],C0,0,0,0),   P1[2],P1[3],P1[4],P1[5],     pw2[0]=PKW(P1,0), pw2[1]=PKW(P1,2), pw2); \
    VRD(6); SBAR(); GAPA(C1=__builtin_amdgcn_mfma_f32_32x32x16_bf16(kf[5],qr[2],C1,0,0,0),   P1[6],P1[7],P1[8],P1[9],     pw2[2]=PKW(P1,4), pw2[3]=PKW(P1,6), pw2); \
    VRD(3); SBAR(); GAPA(C0=__builtin_amdgcn_mfma_f32_32x32x16_bf16(kf[6],qr[3],C0,0,0,0),   P1[10],P1[11],P1[12],P1[13], pw3[0]=PKW(P1,8), pw3[1]=PKW(P1,10), pw3); \
    VRD(7); SBAR(); GAPA(C1=__builtin_amdgcn_mfma_f32_32x32x16_bf16(kf[7],qr[3],C1,0,0,0),   P1[14],P1[15],0.f,0.f,       pw3[2]=PKW(P1,12),pw3[3]=PKW(P1,14), pw3); \
    l_reg+=sacc; \
    if(GK){DMA_K((t)+3,sl_cur);} if(GV){DMA_V((t)+1,sl_next);} \
    CMASK(C0,C1,t); \
    { float a=MX3(C0[0],C0[1],C1[0]),b=MX3(C0[2],C0[3],C1[1]); a=MX3(a,C1[2],C1[3]); \
      _Pragma("unroll") for(int r=4;r<16;r+=4){a=MX3(a,C0[r],C0[r+1]);b=MX3(b,C0[r+2],C0[r+3]);a=MX3(a,C1[r],C1[r+1]);b=MX3(b,C1[r+2],C1[r+3]);} \
      float rm=__builtin_fmaxf(a,b); { auto rr=__builtin_amdgcn_permlane32_swap(__float_as_uint(rm),__float_as_uint(rm),false,false); rm=__builtin_fmaxf(__uint_as_float(rr[0]),__uint_as_float(rr[1])); } \
      resc=false; \
      if(__builtin_expect(__any(rm>(float)THRL),0)){ const float dl=__builtin_fmaxf(rm,0.f); mhat+=dl; \
        _Pragma("unroll") for(int r=0;r<16;++r){C0[r]-=dl;C1[r]-=dl;} \
        _Pragma("unroll") for(int r=0;r<16;++r)negm[r]=-mhat; asm volatile("":"+v"(negm)); \
        const float f=__builtin_amdgcn_exp2f(-dl); l_reg*=f; if(hi==0)wsf[r32]=f; resc=true; } } \
    SBAR(); \
    GAPB(o[0]=__builtin_amdgcn_mfma_f32_32x32x16_bf16(PAF(0),VFR(0),o[0],0,0,0), C0,0); \
    GAPB(o[1]=__builtin_amdgcn_mfma_f32_32x32x16_bf16(PAF(0),VFR(4),o[1],0,0,0), C0,4); \
    KRD(GL,0); GAPB(o[0]=__builtin_amdgcn_mfma_f32_32x32x16_bf16(PAF(1),VFR(1),o[0],0,0,0), C0,8); \
    KRD(GL,1); GAPB(o[1]=__builtin_amdgcn_mfma_f32_32x32x16_bf16(PAF(1),VFR(5),o[1],0,0,0), C0,12); \
    KRD(GL,2); GAPB(o[0]=__builtin_amdgcn_mfma_f32_32x32x16_bf16(PAF(2),VFR(2),o[0],0,0,0), C1,0); \
    KRD(GL,3); GAPB(o[1]=__builtin_amdgcn_mfma_f32_32x32x16_bf16(PAF(2),VFR(6),o[1],0,0,0), C1,4); \
    GAPB(o[0]=__builtin_amdgcn_mfma_f32_32x32x16_bf16(PAF(3),VFR(3),o[0],0,0,0), C1,8); \
    GAPB(o[1]=__builtin_amdgcn_mfma_f32_32x32x16_bf16(PAF(3),VFR(7),o[1],0,0,0), C1,12); \
    }while(0)
  int t=1;
  #undef CMASK
  #define CMASK(P0,P1,t) do{}while(0)
  for(;t+5<NT;t+=2){
    STEP(pB0,pB1,pA0,pA1,t,true,true,true);     WAIT_BAR(2); RESC(); ROT();
    STEP(pA0,pA1,pB0,pB1,t+1,true,true,true);   WAIT_BAR(2); RESC(); ROT();
  }
  #undef CMASK
  #define CMASK(P0,P1,t) do{}while(0)
  #define ENDW(tt) do{ if((tt)+3<NT){WAIT_BAR(2);} else if((tt)+2<NT){WAIT_BAR(1);} else {WAIT_BAR(0);} }while(0)
  for(;t+1<NT;t+=2){
    STEP(pB0,pB1,pA0,pA1,t,(t+3<NT),(t+1<NT),(t+1<NT));       ENDW(t);   RESC(); ROT();
    STEP(pA0,pA1,pB0,pB1,t+1,(t+4<NT),(t+2<NT),(t+2<NT));     ENDW(t+1); RESC(); ROT();
  }
  STEP(pB0,pB1,pA0,pA1,NT-1,false,false,false); RESC();
  { float sacc=pB0[0]+pB0[1]; _Pragma("unroll") for(int r=2;r<16;++r)sacc+=pB0[r]; _Pragma("unroll") for(int r=0;r<16;++r)sacc+=pB1[r]; l_reg+=sacc;
    pw0=(u32x4){PKW(pB0,0),PKW(pB0,2),PKW(pB0,4),PKW(pB0,6)};pw1=(u32x4){PKW(pB0,8),PKW(pB0,10),PKW(pB0,12),PKW(pB0,14)};pw2=(u32x4){PKW(pB1,0),PKW(pB1,2),PKW(pB1,4),PKW(pB1,6)};pw3=(u32x4){PKW(pB1,8),PKW(pB1,10),PKW(pB1,12),PKW(pB1,14)};
    SBAR(); pv(o,vb0+sl_cur,PAF(0),PAF(1),PAF(2),PAF(3)); }
  #undef PKW
  #undef PAF
  #undef VFR
  #undef PIN
  #undef MX3
  #undef GAPA
  #undef GAPB
  #undef EX
  #undef VRD
  #undef KRD
  #undef STEP
  #undef ENDW
  {auto rr=__builtin_amdgcn_permlane32_swap(__float_as_uint(l_reg),__float_as_uint(l_reg),false,false);l_reg=__uint_as_float(rr[0])+__uint_as_float(rr[1]);}
  if(hi==0)wsf[32+r32]=l_reg;asm volatile("s_waitcnt lgkmcnt(0)":::"memory");
  const bf16*Zw0=Z+(rowbase+q0+wid*QBLK)*QP+h*D; u32x4 zz[4];
  #pragma unroll
  for(int i=0;i<4;++i){const int row=i*8+(lane>>3),ch=lane&7; zz[i]=*(const u32x4*)(Zw0+(long)row*QP+ch*8);}
  float rli[16];
  #pragma unroll
  for(int r=0;r<16;++r)rli[r]=__builtin_amdgcn_rcpf(wsf[32+crow(r,hi)]);
  bf16*Ow=O+(rowbase+q0+wid*QBLK)*OP+h*D; const bf16*Zw=Z+(rowbase+q0+wid*QBLK)*QP+h*D;
  { bf16*stg=(bf16*)(shm+LDS_OST)+wid*2048;
    #pragma unroll
    for(int r=0;r<16;++r){const int orow=crow(r,hi);
      #pragma unroll
      for(int d0=0;d0<2;++d0)stg[orow*64+d0*32+r32]=__float2bfloat16(o[d0][r]*rli[r]);}
    asm volatile("s_waitcnt lgkmcnt(0)":::"memory");
    #pragma unroll
    for(int i=0;i<4;++i){const int row=i*8+(lane>>3),ch=lane&7; u32x4 v=*(const u32x4*)(stg+row*64+ch*8); const u32x4 z=zz[i];
      #pragma unroll
      for(int e=0;e<4;++e){ v[e]=cvtpk_s(__uint_as_float(v[e]<<16)*__uint_as_float(z[e]<<16), __uint_as_float(v[e]&0xffff0000u)*__uint_as_float(z[e]&0xffff0000u)); }
      ATTN_STORE16(Ow+(long)row*OP+ch*8,v);} }
  asm volatile("s_waitcnt lgkmcnt(0)\n\ts_barrier":::"memory");
  #undef DMA_K
  #undef DMA_V
  #undef CMASK
  #undef START
  #undef RESC
  #undef ROT
}
constexpr int ATTN_LDS_BYTES=LDS_BYTES;
#undef SBAR
#undef WAIT_BAR
}
#define GAS __attribute__((address_space(1)))
#define LAS __attribute__((address_space(3)))
typedef unsigned short bf16;
typedef unsigned v4u __attribute__((ext_vector_type(4)));
typedef unsigned v2u __attribute__((ext_vector_type(2)));
typedef float f32x4 __attribute__((ext_vector_type(4)));
typedef float f32x16 __attribute__((ext_vector_type(16)));
typedef short bf16x8 __attribute__((ext_vector_type(8)));
typedef short s16x4 __attribute__((ext_vector_type(4)));

constexpr int NWAVES = 8;
constexpr int DMOD = 1024, BATCH = 8, SEQ = 4096, DEPTH = 4, M_TOT = BATCH * SEQ;
constexpr int NCHUNK = 2, BC = BATCH / NCHUNK, MC = BC * SEQ;
constexpr int INW = 6912, PP = 3840;
constexpr int C_QA = 0, C_KA = 512, C_VA = 640, C_ZA = 768, C_UB = 1280, C_VB = 1792, C_ZB = 2304, C_QM = 2816, C_ZM = 3328, C_G = 3840;
constexpr int MEML = 256;
constexpr float EPS = 1e-6f;
constexpr float L2E = 1.4426950408889634f;
constexpr float QSCALE_A = 0.125f * L2E;
constexpr float SC_M = 0.08838834764831845f * L2E;

constexpr size_t MiB = 1u << 20;
constexpr size_t WS_TAB = 0;
constexpr size_t WS_BAR = 512 * 1024, WS_BAR_BYTES = 16384;
constexpr size_t WS_WIN = 1 * MiB;
constexpr size_t WS_WBR = 55 * MiB;
constexpr size_t WS_WOUT = 67 * MiB;
constexpr size_t WS_WKV = 75 * MiB;
constexpr size_t WS_WSB = 83 * MiB;
constexpr size_t WS_MEMN = 84 * MiB;
constexpr size_t WS_KM = 100 * MiB;
constexpr size_t WS_VMT = 108 * MiB;
constexpr size_t WS_H = 116 * MiB;
constexpr size_t WS_Y = 148 * MiB;
constexpr size_t WS_KD = 196 * MiB;
constexpr size_t WS_VD = 200 * MiB;
constexpr size_t WS_XB = 204 * MiB;
constexpr size_t WS_LNP = 242 * MiB;
constexpr size_t WS_SS = 240 * MiB;
constexpr size_t WS_G8 = 388 * MiB;
constexpr size_t WS_P = 268 * MiB;
constexpr size_t WS_END = 484 * MiB;
static_assert(WS_P + (size_t)MC * PP * 2 <= WS_G8 && WS_G8 + (size_t)MC * 3072 <= WS_END, "ws map");

#ifndef USE_MG
#define GEMM_NS mg3
#define GEMM_LDS ldsl
#else
#define GEMM_NS mg
#define GEMM_LDS lds
#endif
constexpr int RST_OFF = 147456, LDS_BYTES = 147456 + 7 * 1024 + 256;
#ifndef P2_ALIGN
#define P2_ALIGN true
#endif
#ifndef P2_SP2
#define P2_SP2 true
#endif
#ifndef REP_P6
#define REP_P6 1
#endif
#ifndef REP_P2
#define REP_P2 1
#endif
#ifndef REP_ATT
#define REP_ATT 1
#endif
#ifndef REP_P5
#define REP_P5 1
#endif
#ifndef REP_M
#define REP_M 1
#endif
#ifndef REP_B
#define REP_B 1
#endif
#ifndef PHM
#define PHM 0xffff
#endif

__device__ __forceinline__ unsigned f2bf(float f) { unsigned u = __builtin_bit_cast(unsigned, f); return (u + 0x7fffu + ((u >> 16) & 1u)) >> 16; }
__device__ __forceinline__ unsigned pk2(float lo, float hi) { return f2bf(lo) | (f2bf(hi) << 16); }
__device__ __forceinline__ float bflo(unsigned u) { return __uint_as_float(u << 16); }
__device__ __forceinline__ float bfhi(unsigned u) { return __uint_as_float(u & 0xffff0000u); }
__device__ __forceinline__ float bf1(bf16 u) { return __uint_as_float((unsigned)u << 16); }
template <int M> __device__ __forceinline__ float swz_xor(float v) { return __builtin_bit_cast(float, __builtin_amdgcn_ds_swizzle(__builtin_bit_cast(int, v), (M << 10) | 0x1f)); }
__device__ __forceinline__ float half_sum(float v) { auto rr = __builtin_amdgcn_permlane32_swap(__float_as_uint(v), __float_as_uint(v), false, false); return __uint_as_float(rr[0]) + __uint_as_float(rr[1]); }
__device__ __forceinline__ float half_max(float v) { auto rr = __builtin_amdgcn_permlane32_swap(__float_as_uint(v), __float_as_uint(v), false, false); return fmaxf(__uint_as_float(rr[0]), __uint_as_float(rr[1])); }
__device__ __forceinline__ float wave_sum(float v) {
    v += swz_xor<1>(v); v += swz_xor<2>(v); v += swz_xor<4>(v); v += swz_xor<8>(v); v += swz_xor<16>(v);
    return half_sum(v);
}
#define LDS_WAIT() asm volatile("s_waitcnt lgkmcnt(0)" ::: "memory")

#define XB_TMO      128
#define XB_XCNT(j)  (256  + 64 * (j))
#define XB_XSUB(j)  (1280 + 64 * (j))
#define XB_XGEN(j)  (2304 + 64 * (j))
#define XB_TOP      3328
#define XB_TOPGEN   3392
#define XCD_BAR_WORDS 3456
#define XB_SPIN_CAP (1u << 18)

__device__ __forceinline__ unsigned xb_ld(unsigned* p)              { return __hip_atomic_load(p, __ATOMIC_RELAXED, __HIP_MEMORY_SCOPE_AGENT); }
__device__ __forceinline__ unsigned xb_add(unsigned* p, unsigned v) { return __hip_atomic_fetch_add(p, v, __ATOMIC_RELAXED, __HIP_MEMORY_SCOPE_AGENT); }
__device__ __forceinline__ unsigned xb_xcc_id() { return (unsigned)__builtin_amdgcn_s_getreg((3 << 11) | 20) & 0xFu; }
#define XB_SPIN(cond, bar) do { unsigned _sp = 0; while (cond) { __builtin_amdgcn_s_sleep(1); \
    if ((++_sp & 255u) == 0u) { if (xb_ld(&(bar)[XB_TMO])) break; if (_sp > XB_SPIN_CAP) { atomicAdd(&(bar)[XB_TMO], 1u); break; } } } } while (0)

struct XcdBarrier {
    unsigned* bar; unsigned x;
    volatile LAS unsigned* st;
};

__device__ __forceinline__ XcdBarrier xcd_barrier_post(unsigned* bar, volatile LAS unsigned* st) {
    XcdBarrier b; b.bar = bar; b.x = xb_xcc_id(); b.st = st;
    if (threadIdx.x == 0) (void)xb_add(&bar[XB_XCNT(b.x)], 1u);
    return b;
}
__device__ __forceinline__ void xcd_barrier_complete(unsigned* bar, unsigned x, unsigned& nloc, unsigned& nx) {
    const unsigned G = gridDim.x * gridDim.y * gridDim.z;
    unsigned sum, cnt, mine, sp = 0u;
    for (;;) {
        sum = 0u; cnt = 0u; mine = 0u;
#pragma unroll
        for (unsigned j = 0; j < 16; ++j) { const unsigned c = xb_ld(&bar[XB_XCNT(j)]); sum += c; cnt += (c > 0u) ? 1u : 0u; mine = (j == x) ? c : mine; }
        if (sum == G) break;
        __builtin_amdgcn_s_sleep(1);
        if ((++sp & 255u) == 0u) { if (xb_ld(&bar[XB_TMO])) break; if (sp > XB_SPIN_CAP) { atomicAdd(&bar[XB_TMO], 1u); break; } }
    }
    nloc = mine > 0u ? mine : 1u; nx = cnt > 0u ? cnt : 1u;
}

__device__ __forceinline__ void xcd_barrier(const XcdBarrier& b) {
    asm volatile("s_waitcnt vmcnt(0)" ::: "memory");
    __syncthreads();
    if (threadIdx.x == 0) {
        unsigned* bar = b.bar;
        __builtin_amdgcn_s_waitcnt(0);
        unsigned nloc = b.st[0], nx = b.st[1];
        if (nloc == 0u) { xcd_barrier_complete(bar, b.x, nloc, nx); b.st[0] = nloc; b.st[1] = nx; }
        const unsigned old = xb_add(&bar[XB_XSUB(b.x)], 1u);
        const unsigned gen = old / nloc;
        if (old + 1u == (gen + 1u) * nloc) {
            __builtin_amdgcn_fence(__ATOMIC_RELEASE, "agent");
            asm volatile("s_waitcnt vmcnt(0)" ::: "memory");
            const unsigned og = xb_add(&bar[XB_TOP], 1u);
            const unsigned tg = og / nx;
            if (og + 1u == (tg + 1u) * nx) xb_add(&bar[XB_TOPGEN], 1u);
            else XB_SPIN(xb_ld(&bar[XB_TOPGEN]) == tg, bar);
            __builtin_amdgcn_fence(__ATOMIC_ACQUIRE, "agent");
            xb_add(&bar[XB_XGEN(b.x)], 1u);
            asm volatile("s_waitcnt vmcnt(0)" ::: "memory");
        } else {
            XB_SPIN(xb_ld(&bar[XB_XGEN(b.x)]) == gen, bar);
            __builtin_amdgcn_fence(__ATOMIC_ACQUIRE, "agent");
            asm volatile("s_waitcnt vmcnt(0)" ::: "memory");
        }
    }
    __syncthreads();
}

struct Args {
    const float* x; const float* mem; const float* norm_g; const float* w_in; const float* q_g; const float* k_g; const float* ln_g; const float* ln_b;
    const float* w_s; const float* b_s; const float* mem_g; const float* w_kv; const float* w_br; const float* w_out; const float* final_g;
    float* out; unsigned char* ws;
};

__device__ __forceinline__ int uz_row(int c) {
    int ch, half;
    if (c >= 1280 && c < 1792) { ch = c - 1280; half = 0; } else if (c >= 2304 && c < 2816) { ch = c - 2304; half = 1; } else return c;
    const int t = ch >> 7, tile = t < 2 ? 5 + t : 7 + t;
    return tile * 256 + ((ch >> 5) & 3) * 64 + ((ch >> 3) & 3) * 16 + half * 8 + (ch & 7);
}
__device__ __forceinline__ void p0_transpose_item(const float* W, int K, int N, bf16* WT, int row_off, LAS float* scr, int item, int lane, const float* kscale = nullptr, bool uzmap = false) {
    const int nblk = N / 32, kb = item / nblk, nb = item % nblk, k0 = 64 * kb, n0 = 32 * nb;
#pragma unroll 8
    for (int i = 0; i < 32; ++i) { const int kk = 2 * i + (lane >> 5); scr[kk * 33 + (lane & 31)] = W[(size_t)(k0 + kk) * N + n0 + (lane & 31)]; }
    LDS_WAIT(); asm volatile("" ::: "memory");
    const int c = lane & 7;
    float ks[8];
#pragma unroll
    for (int e = 0; e < 8; ++e) ks[e] = kscale ? kscale[k0 + 8 * c + e] : 1.0f;
#pragma unroll
    for (int j = 0; j < 4; ++j) { const int n = (lane >> 3) + 8 * j; const LAS float* s = scr + (8 * c) * 33 + n;
        v4u o; o.x = pk2(s[0 * 33] * ks[0], s[1 * 33] * ks[1]); o.y = pk2(s[2 * 33] * ks[2], s[3 * 33] * ks[3]); o.z = pk2(s[4 * 33] * ks[4], s[5 * 33] * ks[5]); o.w = pk2(s[6 * 33] * ks[6], s[7 * 33] * ks[7]);
        *(v4u*)(WT + (size_t)(row_off + (uzmap ? uz_row(n0 + n) : n0 + n)) * K + k0 + 8 * c) = o; }
    LDS_WAIT(); asm volatile("" ::: "memory");
}
__device__ __forceinline__ void rms_row_to_bf16(const float* xrow, const float* g, bf16* orow, int lane) {
    const f32x4* xr = (const f32x4*)xrow + lane; const f32x4* gr = (const f32x4*)g + lane;
    f32x4 v[4]; float s = 0.f;
#pragma unroll
    for (int j = 0; j < 4; ++j) { v[j] = xr[64 * j]; s += (v[j].x * v[j].x + v[j].y * v[j].y) + (v[j].z * v[j].z + v[j].w * v[j].w); }
    const float r = 1.0f / sqrtf(wave_sum(s) * (1.f / DMOD) + EPS);
    v2u* o8 = (v2u*)orow + lane;
#pragma unroll
    for (int j = 0; j < 4; ++j) { const f32x4 gg = gr[64 * j]; v2u o; o.x = pk2(v[j].x * r * gg.x, v[j].y * r * gg.y); o.y = pk2(v[j].z * r * gg.z, v[j].w * r * gg.w); o8[64 * j] = o; }
}
__device__ __forceinline__ void row_to_bf16_ss(const float* xrow, bf16* orow, float* ss, int lane) {
    const f32x4* xr = (const f32x4*)xrow + lane; f32x4 v[4]; float s = 0.f;
#pragma unroll
    for (int j = 0; j < 4; ++j) { v[j] = xr[64 * j]; s += (v[j].x * v[j].x + v[j].y * v[j].y) + (v[j].z * v[j].z + v[j].w * v[j].w); }
    s = wave_sum(s); if (lane < 16) ss[(size_t)lane * MC] = lane == 0 ? s : 0.f;
    v2u* o8 = (v2u*)orow + lane;
#pragma unroll
    for (int j = 0; j < 4; ++j) { v2u o; o.x = pk2(v[j].x, v[j].y); o.y = pk2(v[j].z, v[j].w); o8[64 * j] = o; }
}
__device__ __forceinline__ void rms_row_from_bf16(const bf16* xrow, const float* g, float* orow, int lane) {
    const v2u* xr = (const v2u*)xrow + lane; const f32x4* gr = (const f32x4*)g + lane; f32x4 v[4]; float s = 0.f;
#pragma unroll
    for (int j = 0; j < 4; ++j) { const v2u w = xr[64 * j]; v[j] = (f32x4){bflo(w.x), bfhi(w.x), bflo(w.y), bfhi(w.y)}; s += (v[j].x * v[j].x + v[j].y * v[j].y) + (v[j].z * v[j].z + v[j].w * v[j].w); }
    const float r = 1.0f / sqrtf(wave_sum(s) * (1.f / DMOD) + EPS);
    f32x4* o = (f32x4*)orow + lane;
#pragma unroll
    for (int j = 0; j < 4; ++j) { const f32x4 gg = gr[64 * j]; o[64 * j] = v[j] * r * gg; }
}
__device__ __forceinline__ void rms_row_f32(const float* xrow, const float* g, float* orow, int lane) {
    const f32x4* xr = (const f32x4*)xrow + lane; const f32x4* gr = (const f32x4*)g + lane;
    f32x4 v[4]; float s = 0.f;
#pragma unroll
    for (int j = 0; j < 4; ++j) { v[j] = xr[64 * j]; s += (v[j].x * v[j].x + v[j].y * v[j].y) + (v[j].z * v[j].z + v[j].w * v[j].w); }
    const float r = 1.0f / sqrtf(wave_sum(s) * (1.f / DMOD) + EPS);
    f32x4* o = (f32x4*)orow + lane;
#pragma unroll
    for (int j = 0; j < 4; ++j) { const f32x4 gg = gr[64 * j]; o[64 * j] = v[j] * r * gg; }
}

struct KvOrder {
    int G, c;
    __device__ bool next(int i, pg8::Unit& u) const { const int L = i * G + c; if (L >= 128) return false; const int l = L >> 5, r = L & 31; u.pm = l * 8 + (r >> 2); u.pn = l * 4 + (r & 3); return true; }
    __device__ __forceinline__ void a_ready(const pg8::Unit&) const {}
    __device__ __forceinline__ void done(const pg8::Unit&) const {}
};
struct MergeOrder {
    int G, vcu;
    __device__ bool next(int i, pg8::Unit& u) const { const int t = vcu + G * (i / 3), n = i % 3; if (t >= (MC / 256) * 4) return false; u.pm = n * (MC / 256) + (t >> 2); u.pn = n * 4 + (t & 3); return true; }
    __device__ __forceinline__ void a_ready(const pg8::Unit&) const {}
    __device__ __forceinline__ void done(const pg8::Unit&) const {}
};

typedef f32x4 acc_t[8][4];
__device__ __forceinline__ float sigm(float v) { return __builtin_amdgcn_rcpf(1.0f + __builtin_amdgcn_exp2f(-v * L2E)); }
template <int ACT> __device__ __forceinline__ float act1(float v) { if (ACT == 0) return v; const float s = sigm(v); return ACT == 1 ? v * s : s; }
__device__ __forceinline__ v4u pack8(const float* v) { v4u w; w.x = pg8::cvt_pk_bf16(v[0], v[1]); w.y = pg8::cvt_pk_bf16(v[2], v[3]); w.z = pg8::cvt_pk_bf16(v[4], v[5]); w.w = pg8::cvt_pk_bf16(v[6], v[7]); return w; }
__device__ __forceinline__ float quad_sum(float v) { v += swz_xor<16>(v); return half_sum(v); }
struct EpiIn {
    bf16* P; const float* rst; mutable int cnt;
    bf16* Kd; bf16* Vd; const float* tab; const float* qg; const float* kg; float* lnp;
    unsigned char* G8;
    __device__ __forceinline__ void st_gate(const acc_t& acc, const pg8::Unit& u, int wm, int wn, int fr, int fq) const {
#pragma unroll
        for (int m = 0; m < 8; ++m) { const int row = u.pm * 256 + wm * 128 + 16 * m + fr; const float rs = rst[cnt * 256 + wm * 128 + 16 * m + fr];
            v4u w = {0u, 0u, 0u, 0u};
#pragma unroll
            for (int n = 0; n < 4; ++n)
#pragma unroll
                for (int e = 0; e < 4; ++e) w[n] = __builtin_amdgcn_cvt_pk_u8_f32(sigm(acc[m][n][e] * rs) * 255.0f, e, w[n]);
            *(v4u*)(G8 + (size_t)row * 3072 + (u.pn - 15) * 256 + wn * 64 + 16 * fq) = w; __builtin_amdgcn_sched_barrier(0); }
    }
    template <int ACT, bool LNST> __device__ __forceinline__ void st(const acc_t& acc, const pg8::Unit& u, int wm, int wn, int fr, int fq) const {
#pragma unroll
        for (int m = 0; m < 8; ++m) { const int row = u.pm * 256 + wm * 128 + 16 * m + fr; const float rs = rst[cnt * 256 + wm * 128 + 16 * m + fr];
            float v[16], sm = 0.f, sq = 0.f;
#pragma unroll
            for (int n = 0; n < 4; ++n)
#pragma unroll
                for (int e = 0; e < 4; ++e) { const float t = act1<ACT>(acc[m][n][e] * rs); v[4 * n + e] = t; if (LNST) { sm += t; sq += t * t; } }
            bf16* rowp = P + (size_t)row * PP + u.pn * 256 + wn * 64 + 16 * fq;
            *(v4u*)rowp = pack8(v); *(v4u*)(rowp + 8) = pack8(v + 8);
            if (LNST) { sm = quad_sum(sm); sq = quad_sum(sq); const int slot = (u.pn - 7) * 4 + wn;
                if (fq == 0) { lnp[(size_t)slot * MC + row] = sm; lnp[(size_t)(8 + slot) * MC + row] = sq; } }
            __builtin_amdgcn_sched_barrier(0); }
    }
    __device__ __forceinline__ void head_rope(const f32x4 (&a)[4], float rs, int s, const float* g, float osc, bf16* dst, int fq) const {
        float ssq = 0.f;
#pragma unroll
        for (int n = 0; n < 4; ++n)
#pragma unroll
            for (int e = 0; e < 4; ++e) { const float v = a[n][e] * rs; ssq += v * v; }
        ssq = quad_sum(ssq);
        const float rn = rs / sqrtf(ssq * (1.f / 64.f) + EPS);
        const int pos = (fq >> 1) == 0 ? (s >> 6) : (s & 63); const float* ct = tab + pos * 16; const float* gj = g + 16 * fq; const bool lo = (fq & 1) == 0;
        unsigned pk[8];
#pragma unroll
        for (int n = 0; n < 4; ++n) { const f32x4 c4 = *(const f32x4*)(ct + 4 * n), s4 = *(const f32x4*)(ct + 1024 + 4 * n), g4 = *(const f32x4*)(gj + 4 * n);
            float o[4];
#pragma unroll
            for (int e = 0; e < 4; ++e) { const float y = a[n][e] * rn * g4[e], yp = swz_xor<16>(y);
                o[e] = (lo ? y * c4[e] - yp * s4[e] : y * c4[e] + yp * s4[e]) * osc; }
            pk[2 * n] = pg8::cvt_pk_bf16(o[0], o[1]); pk[2 * n + 1] = pg8::cvt_pk_bf16(o[2], o[3]); }
        *(v4u*)dst = (v4u){pk[0], pk[1], pk[2], pk[3]}; *(v4u*)(dst + 8) = (v4u){pk[4], pk[5], pk[6], pk[7]}; __builtin_amdgcn_sched_barrier(0);
    }
    __device__ __forceinline__ void st_uz(const acc_t& acc, const pg8::Unit& u, int wm, int wn, int fr, int fq) const {
        const int t = u.pn < 7 ? u.pn - 5 : u.pn - 7;
#pragma unroll
        for (int m = 0; m < 8; ++m) { const int row = u.pm * 256 + wm * 128 + 16 * m + fr; const float rs = rst[cnt * 256 + wm * 128 + 16 * m + fr];
            float v[8];
#pragma unroll
            for (int n = 0; n < 2; ++n)
#pragma unroll
                for (int e = 0; e < 4; ++e) v[4 * n + e] = acc[m][n][e] * rs * act1<1>(acc[m][2 + n][e] * rs);
            *(v4u*)(P + (size_t)row * PP + C_UB + 128 * t + 32 * wn + 8 * fq) = pack8(v); __builtin_amdgcn_sched_barrier(0); }
    }
    __device__ __forceinline__ void st_qkv(const acc_t& acc, const pg8::Unit& u, int wm, int wn, int fr, int fq) const {
#pragma unroll
        for (int m = 0; m < 8; ++m) { const int row = u.pm * 256 + wm * 128 + 16 * m + fr, s = row & (SEQ - 1), bl = row >> 12;
            const float rs = rst[cnt * 256 + wm * 128 + 16 * m + fr];
            if (u.pn < 2) head_rope(acc[m], rs, s, qg, QSCALE_A, P + (size_t)row * PP + u.pn * 256 + wn * 64 + 16 * fq, fq);
            else if (wn < 2) head_rope(acc[m], rs, s, kg, 1.0f, Kd + ((size_t)(bl * 2 + wn) * SEQ + s) * 64 + 16 * fq, fq);
            else { bf16* dst = Vd + ((size_t)(bl * 2 + (wn - 2)) * SEQ + s) * 64 + 16 * fq; float v[16];
#pragma unroll
                for (int n = 0; n < 4; ++n)
#pragma unroll
                    for (int e = 0; e < 4; ++e) v[4 * n + e] = acc[m][n][e] * rs;
                *(v4u*)dst = pack8(v); *(v4u*)(dst + 8) = pack8(v + 8); } }
    }
    __device__ __forceinline__ bool operator()(acc_t& acc, const pg8::Unit& u, int wm, int wn, int fr, int fq) const {
        const int pn = u.pn;
        if (pn >= 15) st_gate(acc, u, wm, wn, fr, fq);
        else if (pn == 5 || pn == 6 || pn == 9 || pn == 10) st_uz(acc, u, wm, wn, fr, fq);
        else if (pn == 3 || pn == 4 || pn == 13 || pn == 14) st<1, false>(acc, u, wm, wn, fr, fq);
        else if (pn < 3) st_qkv(acc, u, wm, wn, fr, fq);
        else if (pn == 7 || pn == 8) st<0, true>(acc, u, wm, wn, fr, fq);
        else st<0, false>(acc, u, wm, wn, fr, fq);
        ++cnt;
        return false;
    }
};
struct EpiKv {
    bf16* KM; bf16* VMT;
    __device__ __forceinline__ bool operator()(acc_t& acc, const pg8::Unit& u, int wm, int wn, int fr, int fq) const {
        const int lb = u.pm, jt = u.pn & 3, h = 2 * (jt & 1) + (wn >> 1), d0 = (wn & 1) * 64 + 16 * fq;
#pragma unroll
        for (int m = 0; m < 8; ++m) { const int key = wm * 128 + 16 * m + fr; float v[16];
#pragma unroll
            for (int n = 0; n < 4; ++n)
#pragma unroll
                for (int e = 0; e < 4; ++e) v[4 * n + e] = acc[m][n][e];
            if (jt < 2) { bf16* kp = KM + ((size_t)(lb * 4 + h) * 256 + key) * 128 + d0; *(v4u*)kp = pack8(v); *(v4u*)(kp + 8) = pack8(v + 8); }
            else { bf16* vp = VMT + ((size_t)(lb * 4 + h) * 128 + d0) * 256 + key;
#pragma unroll
                for (int r = 0; r < 16; ++r) vp[r * 256] = (bf16)f2bf(v[r]); } }
        return false;
    }
};
struct EpiMerge {
    const unsigned char* G8; bf16* MG;
    __device__ __forceinline__ bool operator()(acc_t& acc, const pg8::Unit& u, int wm, int wn, int fr, int fq) const {
        const int nb = u.pn >> 2, jt = u.pn & 3, pm = u.pm - nb * (MC / 256);
        constexpr float GMIN = 5.9604645e-8f;
        const int col0 = jt * 256 + wn * 64 + 16 * fq;
#pragma unroll
        for (int m = 0; m < 8; ++m) { const size_t row = (size_t)(pm * 256 + wm * 128 + 16 * m + fr);
            const unsigned char* gp = G8 + row * 3072 + nb * 1024 + col0;
            const v4u g0 = *(const v4u*)gp;
            if (nb < 2) { const v4u h0 = *(const v4u*)(gp + 1024);
#pragma unroll
                for (int n = 0; n < 4; ++n)
#pragma unroll
                    for (int e = 0; e < 4; ++e) { const float g = (float)((g0[n] >> (8 * e)) & 255u) * (1.0f / 255.0f), gn = (float)((h0[n] >> (8 * e)) & 255u) * (1.0f / 255.0f);
                        acc[m][n][e] *= fmaxf(g, GMIN) * __builtin_amdgcn_rcpf(fmaxf(gn, GMIN)); }
            } else { float v[16];
#pragma unroll
                for (int n = 0; n < 4; ++n)
#pragma unroll
                    for (int e = 0; e < 4; ++e) v[4 * n + e] = acc[m][n][e] * fmaxf((float)((g0[n] >> (8 * e)) & 255u) * (1.0f / 255.0f), GMIN);
                *(v4u*)(MG + row * DMOD + col0) = pack8(v); *(v4u*)(MG + row * DMOD + col0 + 8) = pack8(v + 8); }
            __builtin_amdgcn_sched_barrier(0); }
        return nb < 2;
    }
};
struct EpiRes {
    bf16* xb; float* ssn; bool dry;
    __device__ __forceinline__ bool operator()(acc_t& acc, const pg8::Unit& u, int wm, int wn, int fr, int fq) const {
#pragma unroll
        for (int m = 0; m < 8; ++m) { const int row = u.pm * 256 + wm * 128 + 16 * m + fr; const size_t off = (size_t)row * DMOD + u.pn * 256 + wn * 64 + 16 * fq;
            const v4u x0 = *(const v4u*)(xb + off), x1 = *(const v4u*)(xb + off + 8);
            float sq = 0.f, v[16];
#pragma unroll
            for (int n = 0; n < 4; ++n) { const unsigned w0 = n < 2 ? x0[2 * n] : x1[2 * n - 4], w1 = n < 2 ? x0[2 * n + 1] : x1[2 * n - 3];
                v[4 * n] = bflo(w0) + acc[m][n][0]; v[4 * n + 1] = bfhi(w0) + acc[m][n][1]; v[4 * n + 2] = bflo(w1) + acc[m][n][2]; v[4 * n + 3] = bfhi(w1) + acc[m][n][3]; }
            const v4u o0 = pack8(v), o1 = pack8(v + 8);
#pragma unroll
            for (int e = 0; e < 4; ++e) { const float a0 = bflo(o0[e]), a1 = bfhi(o0[e]), b0 = bflo(o1[e]), b1 = bfhi(o1[e]); sq += (a0 * a0 + a1 * a1) + (b0 * b0 + b1 * b1); }
            if (!dry) { *(v4u*)(xb + off) = o0; *(v4u*)(xb + off + 8) = o1; }
            sq = quad_sum(sq);
            if (fq == 0 && !dry) ssn[(size_t)(u.pn * 4 + wn) * MC + row] = sq;
            __builtin_amdgcn_sched_barrier(0); }
        return false;
    }
};

__device__ __forceinline__ void prep_token(int t, bf16* P, bf16* Kd, bf16* Vd, const float* tab, const float* qg, const float* kg, const float* lng, const float* lnb, int lane) {
    bf16* prow = P + (size_t)t * PP;
    const int bl = t / SEQ, s = t % SEQ, rpos = s >> 6, cpos = s & 63;
    {
        const int hd = lane < 40 ? (lane >> 2) : 9, i = lane & 3, seg = i >> 1, fo = (i & 1) * 8;
        const int col = (hd < 8 ? hd * 64 : C_KA + (hd - 8) * 64) + seg * 32 + fo;
        const v4u a = *(const v4u*)(prow + col), b = *(const v4u*)(prow + col + 16);
        float x1[8], x2[8];
#pragma unroll
        for (int e = 0; e < 4; ++e) { x1[2 * e] = bflo(a[e]); x1[2 * e + 1] = bfhi(a[e]); x2[2 * e] = bflo(b[e]); x2[2 * e + 1] = bfhi(b[e]); }
        float ss = 0.f;
#pragma unroll
        for (int e = 0; e < 8; ++e) ss += x1[e] * x1[e] + x2[e] * x2[e];
        ss += swz_xor<1>(ss); ss += swz_xor<2>(ss);
        const float r = 1.0f / sqrtf(ss * (1.f / 64.f) + EPS);
        const float* g = (hd < 8 ? qg : kg) + seg * 32 + fo;
        const int pos = seg == 0 ? rpos : cpos;
        const float* ct = tab + pos * 16 + fo; const float* st = tab + 1024 + pos * 16 + fo;
        const float osc = hd < 8 ? QSCALE_A : 1.0f;
        float o1[8], o2[8];
#pragma unroll
        for (int e = 0; e < 8; ++e) { const float y1 = x1[e] * r * g[e], y2 = x2[e] * r * g[16 + e], c = ct[e], sn = st[e]; o1[e] = (y1 * c - y2 * sn) * osc; o2[e] = (y2 * c + y1 * sn) * osc; }
        v4u w1, w2;
#pragma unroll
        for (int e = 0; e < 4; ++e) { w1[e] = pk2(o1[2 * e], o1[2 * e + 1]); w2[e] = pk2(o2[2 * e], o2[2 * e + 1]); }
        if (lane < 32) { *(v4u*)(prow + col) = w1; *(v4u*)(prow + col + 16) = w2; }
        else if (lane < 40) { bf16* kp = Kd + ((size_t)(bl * 2 + (hd - 8)) * SEQ + s) * 64 + seg * 32 + fo; *(v4u*)kp = w1; *(v4u*)(kp + 16) = w2; }
        else if (lane < 56) { const int j = lane - 40, kvh = j >> 3, d = (j & 7) * 8; *(v4u*)(Vd + ((size_t)(bl * 2 + kvh) * SEQ + s) * 64 + d) = *(const v4u*)(prow + C_VA + j * 8); }
    }
    {
        const v4u a = *(const v4u*)(prow + C_VB + lane * 8);
        float x[8];
#pragma unroll
        for (int e = 0; e < 4; ++e) { x[2 * e] = bflo(a[e]); x[2 * e + 1] = bfhi(a[e]); }
        float sm = 0.f;
#pragma unroll
        for (int e = 0; e < 8; ++e) sm += x[e];
        const float mu = wave_sum(sm) * (1.f / 512.f); float q = 0.f;
#pragma unroll
        for (int e = 0; e < 8; ++e) { x[e] -= mu; q += x[e] * x[e]; }
        const float rstd = 1.0f / sqrtf(wave_sum(q) * (1.f / 512.f) + EPS);
        const f32x4 g0 = *(const f32x4*)(lng + lane * 8), g1 = *(const f32x4*)(lng + lane * 8 + 4), b0 = *(const f32x4*)(lnb + lane * 8), b1 = *(const f32x4*)(lnb + lane * 8 + 4);
        v4u w; w.x = pk2(x[0] * rstd * g0[0] + b0[0], x[1] * rstd * g0[1] + b0[1]); w.y = pk2(x[2] * rstd * g0[2] + b0[2], x[3] * rstd * g0[3] + b0[3]);
        w.z = pk2(x[4] * rstd * g1[0] + b1[0], x[5] * rstd * g1[1] + b1[1]); w.w = pk2(x[6] * rstd * g1[2] + b1[2], x[7] * rstd * g1[3] + b1[3]);
        *(v4u*)(prow + C_VB + lane * 8) = w;
    }
}

__device__ __forceinline__ int crow16(int r, int hi) { return (r & 3) + 8 * (r >> 2) + 4 * hi; }
constexpr int MK_STR = 272, MV_STR = 528;
constexpr int MLDS_K = 0, MLDS_V = 256 * MK_STR, MLDS_SCR = MLDS_V + 128 * MV_STR;
static_assert(MLDS_SCR + 8 * 64 * 4 <= LDS_BYTES, "m-branch lds");
__device__ __forceinline__ void mbranch_unit(int lb, int bl, int h, int tb, const bf16* P, const bf16* KM, const bf16* VMT, bf16* YM, unsigned char* lds) {
    const int tid = opaque_tid(), lane = tid & 63, r32 = lane & 31, hi = lane >> 5, wid = tid >> 6;
    const bf16* Kg = KM + (size_t)(lb * 4 + h) * 256 * 128; const bf16* Vg = VMT + (size_t)(lb * 4 + h) * 128 * 256;
#pragma unroll
    for (int it = 0; it < 8; ++it) { const int i = tid + it * 512, row = i >> 4, ch = i & 15; *(v4u*)(lds + MLDS_K + row * MK_STR + ch * 16) = *(const v4u*)(Kg + row * 128 + ch * 8); }
#pragma unroll
    for (int it = 0; it < 8; ++it) { const int i = tid + it * 512, row = i >> 5, ch = i & 31; *(v4u*)(lds + MLDS_V + row * MV_STR + ch * 16) = *(const v4u*)(Vg + row * 256 + ch * 8); }
    const size_t rowq = (size_t)bl * SEQ + tb * 256 + wid * 32;
    const bf16* qp = P + (rowq + r32) * PP + C_QM + h * 128 + hi * 8;
    bf16x8 qr[8];
#pragma unroll
    for (int d0 = 0; d0 < 8; ++d0) qr[d0] = *(const bf16x8*)(qp + d0 * 16);
    __syncthreads();
    float* scr = (float*)(lds + MLDS_SCR) + wid * 64;
    f32x16 o[4];
#pragma unroll
    for (int dt = 0; dt < 4; ++dt) o[dt] = f32x16{};
    float mrun = -1e30f, lsum = 0.f;
    const unsigned char* kbase = lds + MLDS_K + r32 * MK_STR + hi * 16;
    const unsigned char* vbase = lds + MLDS_V + r32 * MV_STR + hi * 8;
    for (int kb = 0; kb < 4; ++kb) {
        f32x16 s0 = f32x16{}, s1 = f32x16{};
#pragma unroll
        for (int d0 = 0; d0 < 8; ++d0) {
            const bf16x8 a0 = *(const bf16x8*)(kbase + (kb * 64) * MK_STR + d0 * 32), a1 = *(const bf16x8*)(kbase + (kb * 64 + 32) * MK_STR + d0 * 32);
            s0 = __builtin_amdgcn_mfma_f32_32x32x16_bf16(a0, qr[d0], s0, 0, 0, 0); s1 = __builtin_amdgcn_mfma_f32_32x32x16_bf16(a1, qr[d0], s1, 0, 0, 0);
        }
        float mx = fmaxf(s0[0], s1[0]);
#pragma unroll
        for (int r = 1; r < 16; ++r) mx = fmaxf(mx, fmaxf(s0[r], s1[r]));
        mx = half_max(mx);
        const float mnew = fmaxf(mrun, mx * SC_M);
        const float f = __builtin_amdgcn_exp2f(mrun - mnew);
        float ps = 0.f;
#pragma unroll
        for (int r = 0; r < 16; ++r) { s0[r] = __builtin_amdgcn_exp2f(s0[r] * SC_M - mnew); s1[r] = __builtin_amdgcn_exp2f(s1[r] * SC_M - mnew); ps += s0[r] + s1[r]; }
        lsum = lsum * f + ps;
        if (__any(mnew > mrun)) {
            if (hi == 0) scr[r32] = f;
            LDS_WAIT();
#pragma unroll
            for (int r = 0; r < 16; ++r) { const float fr_ = scr[crow16(r, hi)];
#pragma unroll
                for (int dt = 0; dt < 4; ++dt) o[dt][r] *= fr_; }
            LDS_WAIT();
        }
        mrun = mnew;
        bf16x8 pa[4];
#pragma unroll
        for (int g = 0; g < 4; ++g) { v4u w;
#pragma unroll
            for (int e = 0; e < 4; ++e) { const int r = (g & 1) * 8 + 2 * e; w[e] = (g < 2) ? pg8::cvt_pk_bf16(s0[r], s0[r + 1]) : pg8::cvt_pk_bf16(s1[r], s1[r + 1]); }
            pa[g] = __builtin_bit_cast(bf16x8, w); }
#pragma unroll
        for (int g = 0; g < 4; ++g) { const int kk = kb * 64 + (g >> 1) * 32 + (g & 1) * 16;
#pragma unroll
            for (int dt = 0; dt < 4; ++dt) { const unsigned char* vp = vbase + (dt * 32) * MV_STR + kk * 2;
                const s16x4 lo = *(const s16x4*)vp, hh = *(const s16x4*)(vp + 16);
                const bf16x8 vb = (bf16x8){lo[0], lo[1], lo[2], lo[3], hh[0], hh[1], hh[2], hh[3]};
                o[dt] = __builtin_amdgcn_mfma_f32_32x32x16_bf16(pa[g], vb, o[dt], 0, 0, 0); } }
    }
    v4u zg[8];
#pragma unroll
    for (int it = 0; it < 8; ++it) { const int i = it * 64 + lane, row = i >> 4, ch = i & 15; zg[it] = *(const v4u*)(P + (rowq + row) * PP + C_ZM + h * 128 + ch * 8); }
    lsum = half_sum(lsum);
    LDS_WAIT();
    if (hi == 0) scr[r32] = lsum;
    LDS_WAIT();
    float rl[16];
#pragma unroll
    for (int r = 0; r < 16; ++r) rl[r] = __builtin_amdgcn_rcpf(scr[crow16(r, hi)]);
    __syncthreads();
    bf16* stg = (bf16*)(lds + wid * 8704);
#pragma unroll
    for (int r = 0; r < 16; ++r) { const int orow = crow16(r, hi);
#pragma unroll
        for (int dt = 0; dt < 4; ++dt) stg[orow * 136 + dt * 32 + r32] = (bf16)f2bf(o[dt][r] * rl[r]); }
    LDS_WAIT();
#pragma unroll
    for (int it = 0; it < 8; ++it) { const int i = it * 64 + lane, row = i >> 4, ch = i & 15;
        v4u v = *(const v4u*)(stg + row * 136 + ch * 8); const v4u z = zg[it];
#pragma unroll
        for (int e = 0; e < 4; ++e) v[e] = pg8::cvt_pk_bf16(bflo(v[e]) * bflo(z[e]), bfhi(v[e]) * bfhi(z[e]));
        *(v4u*)(YM + (rowq + row) * 512 + h * 128 + ch * 8) = v; }
    __syncthreads();
}

constexpr int BT_STR = 136;
constexpr int BLDS_VN = 0, BLDS_U = 128 * BT_STR * 2, BLDS_Z = 2 * 128 * BT_STR * 2;
constexpr int BLDS_ST = 3 * 128 * BT_STR * 2;
__device__ __forceinline__ void bbranch_unit(int bl, int n, int g, const bf16* P, const float* lnp, const float* lng, const float* lnb, const bf16* Wg  , const float* bs  , bf16* YB, unsigned char* lds) {
    const int tid = opaque_tid(), lane = tid & 63, r32 = lane & 31, hi = lane >> 5, wid = tid >> 6;
    const size_t row0 = (size_t)bl * SEQ + n * 128;
    float* stt = (float*)(lds + BLDS_ST);
    if (tid < 128) { float sm = 0.f, sq = 0.f;
#pragma unroll
        for (int k = 0; k < 8; ++k) { sm += lnp[(size_t)k * MC + row0 + tid]; sq += lnp[(size_t)(8 + k) * MC + row0 + tid]; }
        const float mu = sm * (1.f / 512.f), var = fmaxf(sq * (1.f / 512.f) - mu * mu, 0.f);
        stt[2 * tid] = mu; stt[2 * tid + 1] = 1.0f / sqrtf(var + EPS); }
    __syncthreads();
#pragma unroll
    for (int it = 0; it < 4; ++it) { const int i = tid + it * 512, row = i >> 4, ch = i & 15; const bf16* src = P + (row0 + row) * PP + g * 128 + ch * 8;
        const v4u vv = *(const v4u*)(src + C_VB); const float mu = stt[2 * row], rsd = stt[2 * row + 1];
        const f32x4 g0 = *(const f32x4*)(lng + g * 128 + ch * 8), g1 = *(const f32x4*)(lng + g * 128 + ch * 8 + 4), b0 = *(const f32x4*)(lnb + g * 128 + ch * 8), b1 = *(const f32x4*)(lnb + g * 128 + ch * 8 + 4);
        v4u w; w.x = pk2((bflo(vv.x) - mu) * rsd * g0[0] + b0[0], (bfhi(vv.x) - mu) * rsd * g0[1] + b0[1]); w.y = pk2((bflo(vv.y) - mu) * rsd * g0[2] + b0[2], (bfhi(vv.y) - mu) * rsd * g0[3] + b0[3]);
        w.z = pk2((bflo(vv.z) - mu) * rsd * g1[0] + b1[0], (bfhi(vv.z) - mu) * rsd * g1[1] + b1[1]); w.w = pk2((bflo(vv.w) - mu) * rsd * g1[2] + b1[2], (bfhi(vv.w) - mu) * rsd * g1[3] + b1[3]);
        *(v4u*)(lds + BLDS_VN + (row * BT_STR + ch * 8) * 2) = w;
        *(v4u*)(lds + BLDS_U + (row * BT_STR + ch * 8) * 2) = *(const v4u*)(src + C_UB); }
    __syncthreads();
    const int ct = wid & 3, pt0 = (wid >> 2) * 2;
    const bf16* vn = (const bf16*)(lds + BLDS_VN); bf16* ut = (bf16*)(lds + BLDS_U);
    bf16x8 bfr[8];
#pragma unroll
    for (int k0 = 0; k0 < 8; ++k0) { v4u w;
#pragma unroll
        for (int e = 0; e < 4; ++e) { const int q = k0 * 16 + hi * 8 + 2 * e; w[e] = (unsigned)vn[q * BT_STR + ct * 32 + r32] | ((unsigned)vn[(q + 1) * BT_STR + ct * 32 + r32] << 16); }
        bfr[k0] = __builtin_bit_cast(bf16x8, w); }
#pragma unroll
    for (int pi = 0; pi < 2; ++pi) { const int pt = pt0 + pi;
        f32x16 acc = f32x16{};
#pragma unroll
        for (int k0 = 0; k0 < 8; ++k0) { const bf16x8 a = *(const bf16x8*)(Wg + (pt * 32 + r32) * 128 + k0 * 16 + hi * 8); acc = __builtin_amdgcn_mfma_f32_32x32x16_bf16(a, bfr[k0], acc, 0, 0, 0); }
#pragma unroll
        for (int r = 0; r < 16; ++r) { const int p = pt * 32 + crow16(r, hi), c = ct * 32 + r32;
            const float v = (acc[r] + bs[p]) * bf1(ut[p * BT_STR + c]);
            ut[p * BT_STR + c] = (bf16)f2bf(v); } }
    __syncthreads();
#pragma unroll
    for (int it = 0; it < 4; ++it) { const int i = tid + it * 512, row = i >> 4, ch = i & 15;
        *(v4u*)(YB + (row0 + row) * 512 + g * 128 + ch * 8) = *(const v4u*)(lds + BLDS_U + (row * BT_STR + ch * 8) * 2); }
    __syncthreads();
}


#ifdef DBG_STAGE
#define DBG_DUMP(stage, expr_cols, SRC, PITCH) if (DBG_STAGE == (stage)) { TIDS(); for (int m = gw; m < M_TOT; m += NGW) { float* o = a.out + (size_t)m * DMOD; \
        const int mm = (m + 4321) % MC; for (int cc = lane; cc < DMOD; cc += 64) { float acc_ = 0.f; if (m < MC) { for (int j = cc; j < (expr_cols); j += DMOD) acc_ += bf1((SRC)[(size_t)mm * (PITCH) + j]); } o[cc] = acc_; } } return; }
#else
#define DBG_DUMP(stage, expr_cols, SRC, PITCH)
#endif
__global__ void __launch_bounds__(NWAVES * 64, 2) fwd_kernel(Args a) {
    extern __shared__ __attribute__((aligned(16))) unsigned char lds[];
    cg::grid_group grid = cg::this_grid();
    const int G = gridDim.x, bx = blockIdx.x;
    const int vcu = (G % 8 == 0) ? (bx % 8) * (G / 8) + bx / 8 : bx;
    const int NGW = G * NWAVES;
#define TIDS() const int tid = opaque_tid(), lane = tid & 63, wave = __builtin_amdgcn_readfirstlane(tid >> 6), gw = bx * NWAVES + wave; (void)tid; (void)lane; (void)gw
    unsigned char* ws = a.ws;
    float* tab = (float*)(ws + WS_TAB);
    bf16* WinT = (bf16*)(ws + WS_WIN); bf16* WbrT = (bf16*)(ws + WS_WBR); bf16* WoutT = (bf16*)(ws + WS_WOUT); bf16* WkvT = (bf16*)(ws + WS_WKV); bf16* WsB = (bf16*)(ws + WS_WSB);
    bf16* MEMN = (bf16*)(ws + WS_MEMN); bf16* KM = (bf16*)(ws + WS_KM); bf16* VMT = (bf16*)(ws + WS_VMT);
    unsigned char* G8 = (unsigned char*)(ws + WS_G8);
    bf16* XB = (bf16*)(ws + WS_XB); float* SS = (float*)(ws + WS_SS); float* LNP = (float*)(ws + WS_LNP);
    bf16* H = (bf16*)(ws + WS_H); bf16* Y = (bf16*)(ws + WS_Y); bf16* Kd = (bf16*)(ws + WS_KD); bf16* Vd = (bf16*)(ws + WS_VD); bf16* P = (bf16*)(ws + WS_P);
    PG8_LAS unsigned char* ldsl = (PG8_LAS unsigned char*)lds;
    volatile LAS unsigned* MISC = (volatile LAS unsigned*)(ldsl + (LDS_BYTES - 256));
    if (threadIdx.x < 16) MISC[threadIdx.x] = 0u;
    __syncthreads();
    const XcdBarrier bar = xcd_barrier_post((unsigned*)(ws + WS_BAR), MISC + 8);
    if (a.ws == nullptr) grid.sync();
#ifndef REP_BAR
#define REP_BAR 1
#endif
#define GSYNC() do { for (int rb_ = 0; rb_ < REP_BAR; ++rb_) xcd_barrier(bar); } while (0)

#ifndef REP_PRO
#define REP_PRO 1
#endif
    for (int rp_ = 0; rp_ < REP_PRO; ++rp_) {
    if (PHM & 1) {
        TIDS();
        LAS float* scr = (LAS float*)(ldsl + wave * 16384);
        constexpr int I_IN = 16 * 216, I_KV = 16 * 32, I_BR = 8 * 32, I_OUT = 16 * 32;
        constexpr int N_IN = DEPTH * I_IN, N_KV = DEPTH * I_KV, N_BR = DEPTH * 3 * I_BR, N_OUT = DEPTH * I_OUT;
        for (int it = gw; it < N_IN + N_KV + N_BR + N_OUT; it += NGW) {
            int r = it;
            if (r < N_IN) { const int l = r / I_IN; p0_transpose_item(a.w_in + (size_t)l * DMOD * INW, DMOD, INW, WinT + (size_t)l * INW * DMOD, 0, scr, r % I_IN, lane, a.norm_g + l * DMOD, true); continue; } r -= N_IN;
            if (r < N_KV) { const int l = r / I_KV; p0_transpose_item(a.w_kv + (size_t)l * DMOD * 1024, DMOD, 1024, WkvT + (size_t)l * 1024 * DMOD, 0, scr, r % I_KV, lane); continue; } r -= N_KV;
            if (r < N_BR) { const int ln = r / I_BR, l = ln / 3, n = ln % 3; p0_transpose_item(a.w_br + (size_t)ln * 512 * DMOD, 512, DMOD, WbrT + (size_t)l * 3072 * 512, n * 1024, scr, r % I_BR, lane); continue; } r -= N_BR;
            { const int l = r / I_OUT; p0_transpose_item(a.w_out + (size_t)l * DMOD * DMOD, DMOD, DMOD, WoutT + (size_t)l * DMOD * DMOD, 0, scr, r % I_OUT, lane); }
        }
        for (int i = bx * 512 + tid; i < DEPTH * 4 * 128 * 128 / 2; i += G * 512) { const float2 v = ((const float2*)a.w_s)[i]; ((unsigned*)WsB)[i] = pk2(v.x, v.y); }
        for (int i = bx * 512 + tid; i < 1024; i += G * 512) { const int pos = i >> 4, f = i & 15; const float inv = powf(10000.0f, -(float)f / 16.0f); const float ang = (float)pos * inv; tab[i] = cosf(ang); tab[1024 + i] = sinf(ang); }
        for (int m = gw; m < DEPTH * BATCH * MEML; m += NGW) { const int l = m / (BATCH * MEML), r = m % (BATCH * MEML); rms_row_to_bf16(a.mem + (size_t)r * DMOD, a.mem_g + l * DMOD, MEMN + (size_t)m * DMOD, lane); }
    }
    GSYNC();
    if (PHM & 2) {
        KvOrder S{G, bx}; EpiKv E{KM, VMT};
        GEMM_NS::gemm_phase(GEMM_LDS, MEMN, WkvT, DMOD, S, E);
    }
    if (rp_ + 1 < REP_PRO) GSYNC();
    }
    for (int c = 0; c < NCHUNK; ++c) {
        const size_t xoff = (size_t)c * MC * DMOD;
        for (int l = 0; l < DEPTH; ++l) {
            const float* xin = (l == 0 ? a.x : a.out) + xoff; float* xout = a.out + xoff;
            float* ssc = SS; float* ssn = SS;
            if (l == 0) { TIDS(); for (int m = gw; m < MC; m += NGW) row_to_bf16_ss(xin + (size_t)m * DMOD, XB + (size_t)m * DMOD, ssc + m, lane);
                GSYNC(); }
            DBG_DUMP(6, 1024, H, 1024)
            DBG_DUMP(7, 1024, WinT, 1024)
            if (PHM & 8) {
                pg8::StaticOrder S; S.init(MC, INW, G, bx); float* rst = (float*)(lds + RST_OFF);
                { const int t0 = opaque_tid(); for (int idx = t0; idx < 7 * 256; idx += 512) { pg8::Unit uu; if (!S.next(idx >> 8, uu)) break; const int row = uu.pm * 256 + (idx & 255); float sq = 0.f;
#pragma unroll
                        for (int k = 0; k < 16; ++k) sq += ssc[(size_t)k * MC + row];
                        rst[idx] = 1.0f / sqrtf(sq * (1.f / DMOD) + EPS); } }
                for (int rep_ = 0; rep_ < REP_P2; ++rep_) { EpiIn E{P, rst, 0, Kd, Vd, tab, a.q_g + l * 64, a.k_g + l * 64, LNP, G8}; GEMM_NS::gemm_phase(GEMM_LDS, XB, WinT + (size_t)l * INW * DMOD, DMOD, S, E); }
            }
            GSYNC();
            DBG_DUMP(1, INW, P, PP)
            DBG_DUMP(2, 3840, P, PP)
            DBG_DUMP(3, 128, Kd, 128)
            for (int rep_ = 0; rep_ < REP_ATT; ++rep_) if (PHM & 32) for (int u = bx; u < BC * 8 * (SEQ / 256); u += G) {
                const int grp = u & 7, idx = u >> 3, bl = grp >> 1, kvh = grp & 1, h = kvh * 4 + (idx >> 4), qb = idx & 15;
#ifdef DBG_SIMPLE_ATTN
                { const int tid = opaque_tid();
                  for (int i = tid; i < 256 * 8; i += 512) { const int r = i >> 3, ch = i & 7; const size_t row = (size_t)bl * SEQ + qb * 256 + r;
                    const v4u q = *(const v4u*)(P + row * PP + h * 64 + ch * 8); const v4u k = *(const v4u*)(Kd + ((size_t)(bl * 2 + (h >> 2)) * SEQ + (row % SEQ)) * 64 + ch * 8);
                    const v4u vv = *(const v4u*)(Vd + ((size_t)(bl * 2 + (h >> 2)) * SEQ + ((row + 1234) % SEQ)) * 64 + ch * 8); v4u o;
                    for (int e = 0; e < 4; ++e) o[e] = pk2(bflo(q[e]) * bflo(k[e]) + bflo(vv[e]), bfhi(q[e]) * bfhi(k[e]) + bfhi(vv[e]));
                    *(v4u*)(Y + row * 512 + h * 64 + ch * 8) = o; } }
                if (0)
#endif
                attn_body::attn_unit<8>(bl, h, qb, (const attn_body::bf16*)P, (const attn_body::bf16*)Kd, (const attn_body::bf16*)Vd, (const attn_body::bf16*)(P + C_ZA), (attn_body::bf16*)Y, (char*)lds);
            }
            __syncthreads();
            for (int rep_ = 0; rep_ < REP_M; ++rep_) if (PHM & 64) for (int u = bx; u < BC * 4 * (SEQ / 256); u += G) {
                const int tb = u & 15, h = (u >> 4) & 3, bl = u >> 6;
                mbranch_unit(l * 8 + c * BC + bl, bl, h, tb, P, KM, VMT, Y + (size_t)2 * MC * 512, lds);
            }
            for (int rep_ = 0; rep_ < REP_B; ++rep_) if (PHM & 128) for (int u = bx; u < BC * 32 * 4; u += G) {
                const int g = u & 3, n = (u >> 2) & 31, bl = u >> 7;
                bbranch_unit(bl, n, g, P, LNP, a.ln_g + l * 512, a.ln_b + l * 512, WsB + (size_t)(l * 4 + g) * 128 * 128, a.b_s + (l * 4 + g) * 128, Y + (size_t)MC * 512, lds);
            }
            __syncthreads();
            GSYNC();
            DBG_DUMP(4, 512, Y, 512)
            if (PHM & 256) {
                MergeOrder S{G, vcu}; EpiMerge E{G8, H};
                for (int rep_ = 0; rep_ < REP_P5; ++rep_) GEMM_NS::gemm_phase(GEMM_LDS, Y, WbrT + (size_t)l * 3072 * 512, 512, S, E);
            }
            GSYNC();
            DBG_DUMP(5, 1024, H, 1024)
            if (PHM & 512) {
                pg8::StaticOrder S; S.init(MC, DMOD, G, bx); for (int rep_ = 0; rep_ < REP_P6; ++rep_) { EpiRes E{XB, ssn, rep_ + 1 < REP_P6};
                GEMM_NS::gemm_phase(GEMM_LDS, H, WoutT + (size_t)l * DMOD * DMOD, DMOD, S, E); }
            }
            GSYNC();
        }
        if (PHM & 1024) { TIDS(); for (int m = gw; m < MC; m += NGW) rms_row_from_bf16(XB + (size_t)m * DMOD, a.final_g, a.out + xoff + (size_t)m * DMOD, lane); }
    }
}

extern "C" void kernel_launch(void* const* d_in, const int* in_sizes, int n_in, void* d_out, int out_size, void* d_ws, size_t ws_size, hipStream_t stream) {
    static int grid = 0;
    if (grid == 0) {
        if (n_in != 15 || in_sizes[0] != M_TOT * DMOD || out_size != M_TOT * DMOD || ws_size < WS_END) { fprintf(stderr, "kernel_launch: unexpected shapes (n_in %d, ws %zu)\n", n_in, ws_size); grid = -1; return; }
        int dev = 0, cus = 0, per_cu = 0;
        (void)hipGetDevice(&dev); (void)hipDeviceGetAttribute(&cus, hipDeviceAttributeMultiprocessorCount, dev);
        if (hipFuncSetAttribute((const void*)fwd_kernel, hipFuncAttributeMaxDynamicSharedMemorySize, LDS_BYTES) != hipSuccess) { fprintf(stderr, "kernel_launch: hipFuncSetAttribute failed\n"); grid = -1; return; }
        (void)hipOccupancyMaxActiveBlocksPerMultiprocessor(&per_cu, (const void*)fwd_kernel, NWAVES * 64, LDS_BYTES);
        (void)hipGetLastError();
        grid = cus > 0 ? cus : 256;
    }
    if (grid < 0) return;
    if (hipMemsetAsync((char*)d_ws + WS_BAR, 0, WS_BAR_BYTES, stream) != hipSuccess) { fprintf(stderr, "kernel_launch: memset failed\n"); return; }
    Args a{};
    a.x = (const float*)d_in[0]; a.mem = (const float*)d_in[1]; a.norm_g = (const float*)d_in[2]; a.w_in = (const float*)d_in[3]; a.q_g = (const float*)d_in[4]; a.k_g = (const float*)d_in[5];
    a.ln_g = (const float*)d_in[6]; a.ln_b = (const float*)d_in[7]; a.w_s = (const float*)d_in[8]; a.b_s = (const float*)d_in[9]; a.mem_g = (const float*)d_in[10]; a.w_kv = (const float*)d_in[11];
    a.w_br = (const float*)d_in[12]; a.w_out = (const float*)d_in[13]; a.final_g = (const float*)d_in[14]; a.out = (float*)d_out; a.ws = (unsigned char*)d_ws;
    void* args[] = {&a};
    const hipError_t e = hipLaunchCooperativeKernel((const void*)fwd_kernel, dim3(grid), dim3(NWAVES * 64), args, LDS_BYTES, stream);
    if (e != hipSuccess) fprintf(stderr, "kernel_launch: cooperative launch failed: %s\n", hipGetErrorString(e));
}
```
